# Optimizing an MI355X kernel written in HIP

```python
import jax, jax.numpy as jnp
from jax import lax
import numpy as np

D_MODEL = 1024
BATCH = 8
SEQ = 2048
DEPTH = 4
DEC_BATCH = 32
DEC_SEQ = 8
PAST_LEN = 8192
PAGE_SIZE = 128

N_A = DEPTH // 2
N_B = DEPTH - N_A
POOL_WINDOWS = (2, 4, 8, 16)
N_POOL_GROUPS = len(POOL_WINDOWS)
POOL_GROUP_DIM = D_MODEL // N_POOL_GROUPS
POOL_BUF = max(POOL_WINDOWS) - 1
HEAD_DIM = 64
N_HEADS = D_MODEL // HEAD_DIM
DIL_GROUPS = ((128, 1), (512, 4), (2048, 16))
N_DIL = len(DIL_GROUPS)
MAX_WINDOW = max(w for w, _ in DIL_GROUPS)
BAND = max(w // d for w, d in DIL_GROUPS)
D_FF = 2816
RMS_EPS = 1e-6
NEG_INF = -1e30
ATTN_SCALE = HEAD_DIM ** -0.5

kernel_name = 'yoco_pool_dilated_attn_step'


def alibi_slopes(n):
    return 2.0 ** (-8.0 * jnp.arange(1, n + 1, dtype=jnp.float32) / n)


def rmsnorm(x, g):
    xf = x.astype(jnp.float32)
    y = xf * lax.rsqrt(jnp.mean(xf * xf, axis=-1, keepdims=True) + RMS_EPS)
    return (y * g.astype(jnp.float32)).astype(x.dtype)


def swiglu(x, w_gate, w_up, w_down):
    return (jax.nn.silu(x @ w_gate) * (x @ w_up)) @ w_down


def causal_multiscale_pool(u, prev, pos0):
    b, s, _ = u.shape
    n_prev = prev.shape[1]
    ext = jnp.concatenate([prev, u], axis=1).astype(jnp.float32)
    csum = jnp.pad(jnp.cumsum(ext, axis=1), ((0, 0), (1, 0), (0, 0)))
    end = n_prev + jnp.arange(s) + 1
    pos = pos0 + jnp.arange(s)
    groups = []
    for gi, win in enumerate(POOL_WINDOWS):
        ch = slice(gi * POOL_GROUP_DIM, (gi + 1) * POOL_GROUP_DIM)
        tot = csum[:, end, ch] - csum[:, jnp.maximum(end - win, 0), ch]
        cnt = jnp.minimum(pos + 1, win).astype(jnp.float32)
        groups.append(tot / cnt[None, :, None])
    pooled = jnp.stack(groups, axis=2)
    return pooled - u.astype(jnp.float32).reshape(b, s, N_POOL_GROUPS, POOL_GROUP_DIM)


def pool_mixer(hn, prev, pos0, w_in, w_grp, scale, w_out):
    b, s, d = hn.shape
    u = hn @ w_in
    z = causal_multiscale_pool(u, prev, pos0).astype(hn.dtype)
    z = jnp.einsum('bsgc,gcd->bsgd', z, w_grp).reshape(b, s, d)
    y = (z * scale) @ w_out
    rows = jnp.concatenate([prev, u], axis=1)[:, -POOL_BUF:]
    return y, rows


def softmax_stats(s):
    m = jnp.max(s, axis=-1, keepdims=True)
    p = jnp.exp(s - m)
    l = jnp.sum(p, axis=-1, keepdims=True)
    return p / l, (m + jnp.log(l))[..., 0]


def dilated_band_attn(q, k, v, dil, n_steps, slopes):
    b, s, h, dh = q.shape
    blk = dil * BAND
    sp = -(-s // blk) * blk
    n = sp // dil
    nb = n // BAND

    def split(t):
        t = jnp.pad(t, ((0, 0), (0, sp - s), (0, 0), (0, 0)))
        t = t.reshape(b, n, dil, h, dh).transpose(0, 2, 1, 3, 4)
        return t.reshape(b, dil, nb, BAND, h, dh)

    def with_prev(t):
        prev = jnp.pad(t, ((0, 0), (0, 0), (1, 0), (0, 0), (0, 0), (0, 0)))[:, :, :-1]
        return jnp.concatenate([prev, t], axis=3)

    qb = split(q)
    kk = with_prev(split(k))
    vv = with_prev(split(v))
    sc = jnp.einsum('brnqhe,brnkhe->brnhqk', qb, kk).astype(jnp.float32) * ATTN_SCALE
    qi = jnp.arange(BAND)[:, None]
    ki = jnp.arange(2 * BAND)[None, :]
    step = qi + BAND - ki
    kstep = jnp.arange(nb)[:, None, None] * BAND + ki[None] - BAND
    valid = (step >= 0)[None] & (step <= n_steps)[None] & (kstep >= 0)
    bias = -slopes[:, None, None] * (step * dil).astype(jnp.float32)[None]
    sc = jnp.where(valid[:, None], sc + bias, NEG_INF)
    p, lse = softmax_stats(sc)
    o = jnp.einsum('brnhqk,brnkhe->brnqhe', p.astype(v.dtype), vv)
    o = o.reshape(b, dil, n, h, dh).transpose(0, 2, 1, 3, 4).reshape(b, sp, h, dh)[:, :s]
    lse = lse.transpose(0, 1, 2, 4, 3).reshape(b, dil, n, h).transpose(0, 2, 1, 3).reshape(b, sp, h)[:, :s]
    return o, lse


def dilated_gather_attn(q, k_all, v_all, n_past, dil, n_steps, slopes):
    t = q.shape[1]
    dist = jnp.arange(n_steps + 1) * dil
    idx = n_past + jnp.arange(t)[:, None] - dist[None, :]
    valid = idx >= 0
    idx = jnp.maximum(idx, 0)
    kg = k_all[:, idx]
    vg = v_all[:, idx]
    sc = jnp.einsum('bthe,btkhe->bhtk', q, kg).astype(jnp.float32) * ATTN_SCALE
    sc = sc - slopes[:, None, None] * dist.astype(jnp.float32)[None, None, :]
    sc = jnp.where(valid[None, None], sc, NEG_INF)
    p, lse = softmax_stats(sc)
    o = jnp.einsum('bhtk,btkhe->bthe', p.astype(v_all.dtype), vg)
    return o, lse.transpose(0, 2, 1)


def dilated_mixer(hn, w_q, w_o, k_all, v_all, n_past, banded, slopes):
    b, s, d = hn.shape
    q = (hn @ w_q).reshape(b, s, N_DIL, N_HEADS, HEAD_DIM)
    outs, lses = [], []
    for gi, (win, dil) in enumerate(DIL_GROUPS):
        if banded:
            o, lse = dilated_band_attn(q[:, :, gi], k_all, v_all, dil, win // dil, slopes)
        else:
            o, lse = dilated_gather_attn(q[:, :, gi], k_all, v_all, n_past, dil, win // dil, slopes)
        outs.append(o)
        lses.append(lse)
    wts = jax.nn.softmax(jnp.stack(lses), axis=0)
    o = jnp.sum(wts[..., None] * jnp.stack(outs).astype(jnp.float32), axis=0)
    return o.reshape(b, s, d).astype(hn.dtype) @ w_o


def trunk(x, pool_prev, k_past, v_past, pos0, norm_g, ffn_w_gate, ffn_w_up, ffn_w_down,
          pool_w_in, pool_w_grp, pool_scale, pool_w_out, kv_norm, w_k, w_v, attn_w_q, attn_w_o):
    b, s, _ = x.shape
    slopes = alibi_slopes(N_HEADS)
    banded = k_past is None
    h = x
    pool_rows = []
    k_all = v_all = None
    n_past = 0
    buf = 0
    for layer in range(DEPTH):
        if layer == N_A:
            kvn = rmsnorm(h, kv_norm)
            k_new = (kvn @ w_k).reshape(b, s, N_HEADS, HEAD_DIM)
            v_new = (kvn @ w_v).reshape(b, s, N_HEADS, HEAD_DIM)
            if banded:
                k_all, v_all = k_new, v_new
                buf = min(MAX_WINDOW, s)
            else:
                n_past = k_past.shape[1]
                k_all = jnp.concatenate([k_past, k_new], axis=1)
                v_all = jnp.concatenate([v_past, v_new], axis=1)
                buf = n_past
        g = norm_g[layer]
        f = swiglu(rmsnorm(h, g[0]), ffn_w_gate[layer, 0], ffn_w_up[layer, 0], ffn_w_down[layer, 0])
        h = h + 0.5 * rmsnorm(f, g[1])
        hn = rmsnorm(h, g[2])
        if layer < N_A:
            y, rows = pool_mixer(hn, pool_prev[layer], pos0, pool_w_in[layer], pool_w_grp[layer],
                                 pool_scale[layer], pool_w_out[layer])
            pool_rows.append(rows)
        else:
            j = layer - N_A
            y = dilated_mixer(hn, attn_w_q[j], attn_w_o[j], k_all, v_all, n_past, banded, slopes)
        h = h + rmsnorm(y, g[3])
        f = swiglu(rmsnorm(h, g[4]), ffn_w_gate[layer, 1], ffn_w_up[layer, 1], ffn_w_down[layer, 1])
        h = h + 0.5 * rmsnorm(f, g[5])
    return h, jnp.stack(pool_rows), k_all[:, -buf:], v_all[:, -buf:]


def setup_inputs(seed: int = 0) -> dict:
    key = jax.random.key(seed)
    ks = jax.random.split(key, 20)
    nrm = jax.random.normal
    kv_buf = min(MAX_WINDOW, PAST_LEN)
    d, f, c = D_MODEL, D_FF, POOL_GROUP_DIM
    return {
        'x_prompt': nrm(ks[0], (BATCH, SEQ, d), jnp.float32),
        'x_sample': nrm(ks[1], (DEC_BATCH, DEC_SEQ, d), jnp.float32),
        'state_pool': nrm(ks[2], (N_A, DEC_BATCH, POOL_BUF, d), jnp.float32),
        'cache_k': nrm(ks[3], (DEC_BATCH, kv_buf, N_HEADS, HEAD_DIM), jnp.float32),
        'cache_v': nrm(ks[4], (DEC_BATCH, kv_buf, N_HEADS, HEAD_DIM), jnp.float32),
        'norm_g': 1.0 + 0.05 * nrm(ks[5], (DEPTH, 6, d), jnp.float32),
        'ffn_w_gate': nrm(ks[6], (DEPTH, 2, d, f), jnp.float32) * d ** -0.5,
        'ffn_w_up': nrm(ks[7], (DEPTH, 2, d, f), jnp.float32) * d ** -0.5,
        'ffn_w_down': nrm(ks[8], (DEPTH, 2, f, d), jnp.float32) * f ** -0.5,
        'pool_w_in': nrm(ks[9], (N_A, d, d), jnp.float32) * d ** -0.5,
        'pool_w_grp': nrm(ks[10], (N_A, N_POOL_GROUPS, c, c), jnp.float32) * c ** -0.5,
        'pool_scale': 1.0 + 0.1 * nrm(ks[11], (N_A, d), jnp.float32),
        'pool_w_out': nrm(ks[12], (N_A, d, d), jnp.float32) * d ** -0.5,
        'kv_norm': 1.0 + 0.05 * nrm(ks[13], (d,), jnp.float32),
        'w_k': nrm(ks[14], (d, d), jnp.float32) * d ** -0.5,
        'w_v': nrm(ks[15], (d, d), jnp.float32) * d ** -0.5,
        'attn_w_q': nrm(ks[16], (N_B, d, N_DIL * d), jnp.float32) * d ** -0.5,
        'attn_w_o': nrm(ks[17], (N_B, d, d), jnp.float32) * d ** -0.5,
    }


def reference(x_prompt, x_sample, state_pool, cache_k, cache_v, norm_g, ffn_w_gate, ffn_w_up,
              ffn_w_down, pool_w_in, pool_w_grp, pool_scale, pool_w_out, kv_norm, w_k, w_v,
              attn_w_q, attn_w_o):
    empty_pool = jnp.zeros((N_A, x_prompt.shape[0], 0, D_MODEL), x_prompt.dtype)
    y_prompt, pool_p, k_p, v_p = trunk(
        x_prompt, empty_pool, None, None, 0, norm_g, ffn_w_gate, ffn_w_up, ffn_w_down,
        pool_w_in, pool_w_grp, pool_scale, pool_w_out, kv_norm, w_k, w_v, attn_w_q, attn_w_o)
    y_sample, pool_s, k_s, v_s = trunk(
        x_sample, state_pool, cache_k, cache_v, PAST_LEN, norm_g, ffn_w_gate, ffn_w_up, ffn_w_down,
        pool_w_in, pool_w_grp, pool_scale, pool_w_out, kv_norm, w_k, w_v, attn_w_q, attn_w_o)
    return (y_prompt, y_sample, pool_p, k_p, v_p, pool_s, k_s, v_s)
```

```cpp
#include <hip/hip_runtime.h>
#include <hip/hip_cooperative_groups.h>
#include <cstdio>
#include <cstdint>
namespace cg = cooperative_groups;

#ifndef MK_ONE_LAUNCH
#define MK_ONE_LAUNCH 0
#endif

#define LAS __attribute__((address_space(3)))
typedef unsigned short bf16_t;
typedef short bf16x8 __attribute__((ext_vector_type(8)));
typedef short s16x4 __attribute__((ext_vector_type(4)));
typedef float f32x4 __attribute__((ext_vector_type(4)));
typedef float f32x2 __attribute__((ext_vector_type(2)));
typedef float f32x16 __attribute__((ext_vector_type(16)));
typedef unsigned u32x4 __attribute__((ext_vector_type(4)));
typedef unsigned u32x2 __attribute__((ext_vector_type(2)));
typedef __bf16 bf16v2 __attribute__((ext_vector_type(2)));

__device__ __forceinline__ unsigned pk2(float lo, float hi) { f32x2 v = {lo, hi}; bf16v2 r = __builtin_convertvector(v, bf16v2); return __builtin_bit_cast(unsigned, r); }
__device__ __forceinline__ float bf_lo(unsigned w) { return __uint_as_float(w << 16); }
__device__ __forceinline__ float bf_hi(unsigned w) { return __uint_as_float(w & 0xffff0000u); }

constexpr int D = 1024, FF = 2816, MP = 16384, MS = 256, M = MP + MS, SEQ = 2048, NB = 8, DB = 32, DT = 8, KVB = 2048, SROWS = KVB + DT;
constexpr int NH = 16, HD = 64, NQ = 3 * D;
constexpr float EPS = 1e-6f;
constexpr size_t O_YP = 0, O_YS = 16777216, O_PP = 17039360, O_KP = 17285120, O_VP = 34062336, O_PS = 50839552, O_KS = 51822592, O_VS = 118931456;
constexpr size_t MiB = 1u << 20;
constexpr size_t WS_FFN = 1 * MiB;
constexpr size_t FFN_STRIDE = 17301504, WD_OFF = 11534336;
constexpr size_t WS_WIN = 133 * MiB, WS_WEFF = 137 * MiB, WS_WKV = 141 * MiB, WS_WQ = 145 * MiB, WS_WO = 157 * MiB;
constexpr size_t WS_H = 161 * MiB;
constexpr size_t WS_XN = 226 * MiB;
constexpr size_t WS_XN2 = WS_XN + 34078720;
constexpr size_t WS_ACT = 291 * MiB;
constexpr size_t WS_F = WS_ACT + 102236160;
constexpr size_t WS_PART = WS_F + 68157440;
constexpr size_t WS_OG = WS_PART + 22 * MiB + MiB / 2;
constexpr size_t WS_LSE = WS_OG + 102236160;
constexpr size_t WS_KB = 577 * MiB, WS_VB = 609 * MiB;
constexpr size_t WS_KBS = 641 * MiB;
constexpr size_t WS_VBS = WS_KBS + 134742016;
constexpr size_t WS_END = WS_VBS + 134742016;
static_assert(WS_LSE + 3 * (size_t)M * 16 * 4 <= WS_KB, "ws map");

constexpr int LDS_BYTES = 147456;
constexpr int NWAVES = 8;

namespace pg8 {
constexpr int BM = 256, BK = 64, HALF = 128, HTB = HALF * BK * 2, STAGE_BYTES = 8 * HTB;
__device__ __forceinline__ int lds_byte(int r, int c) { const int st = (r >> 4) * 2 + (c >> 5), rr = r & 15, cc = c & 31, ob = rr * 64 + cc * 2; return st * 1024 + (ob ^ (((ob >> 9) & 1) << 5)); }
__device__ __forceinline__ void stage_rc(int b, int& R, int& C) { const int st = b / 1024, sb = b % 1024, swz = sb ^ (((sb >> 9) & 1) << 5); R = (st >> 1) * 16 + swz / 64; C = (st & 1) * 32 + (swz % 64) / 2; }
__device__ __forceinline__ int perm32(int rho) { const int n = rho >> 4, i = rho & 15; return 8 * (i >> 2) + 4 * n + (i & 3); }

struct Unit { const char* A; const char* B; int nt, pm, pn, ks; };

struct Sched {
    const char* A; const char* Bt; int ld, nN, nwgP, G, c, nsplit, ntf;
    __device__ __forceinline__ void init(const bf16_t* A_, const bf16_t* Bt_, int N, int K, int nsplit_, int G_, int c_) {
        A = (const char*)A_; Bt = (const char*)Bt_; ld = K; nN = N / BM; nwgP = 64 * nN; G = G_; c = c_; nsplit = nsplit_; ntf = K / BK; }
    __device__ __forceinline__ bool next(int i, Unit& u) const {
        long L = (long)i * G + c; const size_t tstep = (size_t)BM * ld * 2;
        if (L < nwgP) {
            int wgid = (int)L; { const int q = nwgP / 8, xcd = wgid % 8, off = wgid / 8; wgid = xcd * q + off; }
            const int nig = 8 * nN, gid = wgid / nig, fm = gid * 8;
            u.pm = fm + ((wgid % nig) % 8); u.pn = (wgid % nig) / 8; u.ks = 0; u.nt = ntf;
            u.A = A + (size_t)u.pm * tstep; u.B = Bt + (size_t)u.pn * tstep; return true;
        }
        L -= nwgP; if (L >= (long)nN * nsplit) return false;
        u.pm = 64; u.pn = (int)(L % nN); u.ks = (int)(L / nN); u.nt = ntf / nsplit;
        const size_t koff = (size_t)u.ks * u.nt * (BK * 2);
        u.A = A + 64 * tstep + koff; u.B = Bt + (size_t)u.pn * tstep + koff; return true;
    }
};

__device__ __forceinline__ float silu_mul(float g, float u) { return g * u * __builtin_amdgcn_rcpf(1.0f + __expf(-g)); }

struct EpiSwiglu {
    static constexpr bool PERM = true;
    bf16_t* O;
    __device__ __forceinline__ void operator()(const f32x4 (&acc)[2][2][4][2], const Unit& u, int wr, int wc, int fr, int fq) const {
        asm volatile("" : "+v"(fr), "+v"(fq));
        const int col0 = u.pn * HALF + wc * 32 + 8 * fq;
#pragma unroll
        for (int ai = 0; ai < 2; ++ai)
#pragma unroll
            for (int m = 0; m < 4; ++m) {
                bf16_t* rowp = O + (size_t)(u.pm * BM + ai * HALF + wr * 64 + m * 16 + fr) * FF + col0;
                const f32x4 g0 = acc[ai][0][m][0], g1 = acc[ai][0][m][1], u0 = acc[ai][1][m][0], u1 = acc[ai][1][m][1];
                u32x4 w;
                w.x = pk2(silu_mul(g0[0], u0[0]), silu_mul(g0[1], u0[1])); w.y = pk2(silu_mul(g0[2], u0[2]), silu_mul(g0[3], u0[3]));
                w.z = pk2(silu_mul(g1[0], u1[0]), silu_mul(g1[1], u1[1])); w.w = pk2(silu_mul(g1[2], u1[2]), silu_mul(g1[3], u1[3]));
                *(u32x4*)rowp = w;
            }
    }
};
struct EpiQ {
    static constexpr bool PERM = true;
    bf16_t* O; float scale;
    __device__ __forceinline__ void operator()(const f32x4 (&acc)[2][2][4][2], const Unit& u, int wr, int wc, int fr, int fq) const {
        asm volatile("" : "+v"(fr), "+v"(fq));
        const int col0 = u.pn * BM + wc * 32 + 8 * fq;
#pragma unroll
        for (int ai = 0; ai < 2; ++ai)
#pragma unroll
            for (int m = 0; m < 4; ++m) {
                bf16_t* rowp = O + (size_t)(u.pm * BM + ai * HALF + wr * 64 + m * 16 + fr) * NQ + col0;
#pragma unroll
                for (int bj = 0; bj < 2; ++bj) { const f32x4 v0 = acc[ai][bj][m][0] * scale, v1 = acc[ai][bj][m][1] * scale;
                    u32x4 w; w.x = pk2(v0[0], v0[1]); w.y = pk2(v0[2], v0[3]); w.z = pk2(v1[0], v1[1]); w.w = pk2(v1[2], v1[3]);
                    *(u32x4*)(rowp + bj * HALF) = w; }
            }
    }
};
struct EpiF32 {
    static constexpr bool PERM = false;
    float* F; float* P;
    __device__ __forceinline__ void operator()(const f32x4 (&acc)[2][2][4][2], const Unit& u, int wr, int wc, int fr, int fq) const {
        asm volatile("" : "+v"(fr), "+v"(fq));
        float* base = (u.pm < 64) ? F + (size_t)u.pm * BM * D : P + (size_t)u.ks * BM * D;
        const int col0 = u.pn * BM + wc * 32 + 4 * fq;
#pragma unroll
        for (int ai = 0; ai < 2; ++ai)
#pragma unroll
            for (int m = 0; m < 4; ++m) {
                float* rowp = base + (size_t)(ai * HALF + wr * 64 + m * 16 + fr) * D + col0;
#pragma unroll
                for (int bj = 0; bj < 2; ++bj)
#pragma unroll
                    for (int n = 0; n < 2; ++n) *(f32x4*)(rowp + bj * HALF + n * 16) = acc[ai][bj][m][n];
                asm volatile("" ::: "memory");
            }
    }
};
struct EpiKV {
    static constexpr bool PERM = false;
    float *oKp, *oVp, *oKs, *oVs; bf16_t *KB, *VB, *KBS, *VBS;
    __device__ __forceinline__ void operator()(const f32x4 (&acc)[2][2][4][2], const Unit& u, int wr, int wc, int fr, int fq) const {
        asm volatile("" : "+v"(fr), "+v"(fq));
        const bool isV = u.pn >= 4; const int col0 = (u.pn & 3) * BM + wc * 32 + 4 * fq;
#pragma unroll
        for (int ai = 0; ai < 2; ++ai)
#pragma unroll
            for (int m = 0; m < 4; ++m) {
                const int lrow = ai * HALF + wr * 64 + m * 16 + fr; float* fo; bf16_t* bo;
                if (u.pm < 64) { const size_t g = (size_t)(u.pm * BM + lrow) * D; fo = (isV ? oVp : oKp) + g; bo = (isV ? VB : KB) + g; }
                else { const int b = lrow >> 3, t = lrow & 7; fo = (isV ? oVs : oKs) + ((size_t)b * KVB + (KVB - DT) + t) * D; bo = (isV ? VBS : KBS) + ((size_t)b * SROWS + KVB + t) * D; }
#pragma unroll
                for (int bj = 0; bj < 2; ++bj)
#pragma unroll
                    for (int n = 0; n < 2; ++n) { const f32x4 v = acc[ai][bj][m][n]; const int c = col0 + bj * HALF + n * 16;
                        *(f32x4*)(fo + c) = v; u32x2 w; w.x = pk2(v[0], v[1]); w.y = pk2(v[2], v[3]); *(u32x2*)(bo + c) = w; }
                asm volatile("" ::: "memory");
            }
    }
};

template <class Epi>
__device__ __forceinline__ void gemm_phase(LAS unsigned char* lds, const Sched& S, const Epi& E, int tid) {
    const int wid = __builtin_amdgcn_readfirstlane(tid >> 6), lane = tid & 63, wr = wid >> 2, wc = wid & 3, fr = lane & 15, fq = lane >> 4;
    const int ld = S.ld;
    unsigned voffA[2], voffB[2];
#pragma unroll
    for (int i = 0; i < 2; ++i) { int R, C; stage_rc(tid * 16 + i * 8192, R, C); const int Rb = Epi::PERM ? ((R & ~31) + perm32(R & 31)) : R;
        voffA[i] = (unsigned)(R * ld + C) * 2u; voffB[i] = (unsigned)(Rb * ld + C) * 2u; }
    const size_t kstep = (size_t)(BK * 2);
    const size_t hstep = (size_t)HALF * ld * 2;
    const unsigned ldsw = (unsigned)wid * 1024u;
    const int aoff = lds_byte(wr * 64 + fr, fq * 8), boff = lds_byte(wc * 32 + fr, fq * 8);
#define PG8_SA(b, h) (((b) * 2 + (h)) * HTB)
#define PG8_SB(b, h) ((4 + (b) * 2 + (h)) * HTB)
#define PG8_STAGE(bufoff, gbase, voff) do { _Pragma("unroll") for (int _i = 0; _i < 2; ++_i) \
        __builtin_amdgcn_global_load_lds((const unsigned*)((const char*)(gbase) + (voff)[_i]), (LAS unsigned*)(lds + (bufoff) + ldsw + _i * 8192), 16, 0, 0); } while (0)
#define PG8_LDA(dst, b, h) do { _Pragma("unroll") for (int m = 0; m < 4; ++m) _Pragma("unroll") for (int k = 0; k < 2; ++k) dst[m][k] = *(const LAS bf16x8*)(lds + PG8_SA(b, h) + aoff + m * 2048 + k * 1024); } while (0)
#define PG8_LDB(dst, b, h) do { _Pragma("unroll") for (int n = 0; n < 2; ++n) _Pragma("unroll") for (int k = 0; k < 2; ++k) dst[n][k] = *(const LAS bf16x8*)(lds + PG8_SB(b, h) + boff + n * 2048 + k * 1024); } while (0)
#define PG8_MMA(ai, bj, At, Bt) do { __builtin_amdgcn_s_setprio(1); _Pragma("unroll") for (int m = 0; m < 4; ++m) _Pragma("unroll") for (int n = 0; n < 2; ++n) _Pragma("unroll") for (int k = 0; k < 2; ++k) \
        acc[ai][bj][m][n] = __builtin_amdgcn_mfma_f32_16x16x32_bf16(Bt[n][k], At[m][k], acc[ai][bj][m][n], 0, 0, 0); __builtin_amdgcn_s_setprio(0); } while (0)
#define PG8_WAIT_V(n) asm volatile("s_waitcnt vmcnt(" #n ")" ::: "memory")
#define PG8_WAIT_L(n) asm volatile("s_waitcnt lgkmcnt(" #n ")" ::: "memory")
#define PG8_BAR __builtin_amdgcn_s_barrier()
#define PG8_SCHED __builtin_amdgcn_sched_barrier(0)
    Unit cur, nxt; int ui = 0;
    if (!S.next(0, cur)) return;
    f32x4 acc[2][2][4][2];
#pragma unroll
    for (int a = 0; a < 2; ++a)
#pragma unroll
        for (int b = 0; b < 2; ++b)
#pragma unroll
            for (int m = 0; m < 4; ++m)
#pragma unroll
                for (int n = 0; n < 2; ++n) acc[a][b][m][n] = (f32x4){0.f, 0.f, 0.f, 0.f};
    bf16x8 At[4][2], B0[2][2], B1[2][2];
    const char* cA = cur.A; const char* cB = cur.B;
    PG8_STAGE(PG8_SB(0, 0), cB, voffB); PG8_STAGE(PG8_SB(0, 1), cB + hstep, voffB); PG8_STAGE(PG8_SA(0, 0), cA, voffA); PG8_STAGE(PG8_SA(0, 1), cA + hstep, voffA);
    if (wr == 1) PG8_BAR;
    PG8_WAIT_V(2); PG8_BAR;
    PG8_STAGE(PG8_SB(1, 0), cB + kstep, voffB); PG8_STAGE(PG8_SA(1, 0), cA + kstep, voffA); PG8_STAGE(PG8_SB(1, 1), cB + hstep + kstep, voffB);
    PG8_WAIT_V(6); PG8_BAR;
    for (;;) {
        const bool has_next = S.next(ui + 1, nxt);
        const char* nA = has_next ? nxt.A : cA; const char* nB = has_next ? nxt.B : cB;
        const int nt = cur.nt;
        for (int t = 0; t < nt; t += 2) {
            const bool last = (t == nt - 2);
            const char* a1 = cA + (size_t)(t + 1) * kstep;
            const char* a2 = last ? nA : cA + (size_t)(t + 2) * kstep; const char* b2 = last ? nB : cB + (size_t)(t + 2) * kstep;
            const char* a3 = a2 + kstep; const char* b3 = b2 + kstep;
            PG8_LDB(B0, 0, 0); PG8_LDB(B1, 0, 1); PG8_SCHED; PG8_LDA(At, 0, 0); PG8_STAGE(PG8_SA(1, 1), a1 + hstep, voffA);
            PG8_WAIT_V(8); PG8_WAIT_L(0); PG8_BAR; PG8_MMA(0, 0, At, B0); PG8_MMA(0, 1, At, B1); PG8_BAR; PG8_SCHED;
            PG8_LDA(At, 0, 1); PG8_STAGE(PG8_SB(0, 0), b2, voffB); PG8_STAGE(PG8_SB(0, 1), b2 + hstep, voffB); PG8_STAGE(PG8_SA(0, 0), a2, voffA);
            PG8_WAIT_V(8); PG8_WAIT_L(0); PG8_BAR; PG8_MMA(1, 0, At, B0); PG8_MMA(1, 1, At, B1); PG8_BAR; PG8_SCHED;
            PG8_LDB(B0, 1, 0); PG8_LDB(B1, 1, 1); PG8_SCHED; PG8_LDA(At, 1, 0); PG8_STAGE(PG8_SA(0, 1), a2 + hstep, voffA);
            PG8_WAIT_V(8); PG8_WAIT_L(0); PG8_BAR; PG8_MMA(0, 0, At, B0); PG8_MMA(0, 1, At, B1); PG8_BAR; PG8_SCHED;
            PG8_LDA(At, 1, 1); PG8_STAGE(PG8_SB(1, 0), b3, voffB); PG8_STAGE(PG8_SB(1, 1), b3 + hstep, voffB); PG8_STAGE(PG8_SA(1, 0), a3, voffA);
            PG8_WAIT_V(8); PG8_WAIT_L(0); PG8_BAR; PG8_MMA(1, 0, At, B0); PG8_MMA(1, 1, At, B1); PG8_BAR; PG8_SCHED;
        }
        if (wr == 0) PG8_BAR;
        E(acc, cur, wr, wc, fr, fq);
        if (!has_next) break;
#pragma unroll
        for (int a = 0; a < 2; ++a)
#pragma unroll
            for (int b = 0; b < 2; ++b)
#pragma unroll
                for (int m = 0; m < 4; ++m)
#pragma unroll
                    for (int n = 0; n < 2; ++n) acc[a][b][m][n] = (f32x4){0.f, 0.f, 0.f, 0.f};
        cur = nxt; cA = nA; cB = nB; ++ui;
        if (wr == 1) PG8_BAR;
    }
    PG8_WAIT_V(0);
    PG8_BAR;
#undef PG8_SA
#undef PG8_SB
#undef PG8_STAGE
#undef PG8_LDA
#undef PG8_LDB
#undef PG8_MMA
#undef PG8_WAIT_V
#undef PG8_WAIT_L
#undef PG8_BAR
#undef PG8_SCHED
}
}

struct Args { const float* in[18]; float* out; unsigned char* ws; int ph_lo, ph_hi; };
struct Ctx { int lane, wave, gw, NGW, G; };

__device__ __forceinline__ float lane_xor(float v, int lane, int mask) { return __int_as_float(__builtin_amdgcn_ds_bpermute((lane ^ mask) << 2, __float_as_int(v))); }
__device__ __forceinline__ float wave_sum(float v, int lane) {
#pragma unroll
    for (int o = 1; o < 64; o <<= 1) v += lane_xor(v, lane, o);
    return v;
}
__device__ __forceinline__ float ss4(const f32x4 v) { return (v.x * v.x + v.y * v.y) + (v.z * v.z + v.w * v.w); }

__device__ __forceinline__ void tr_item(const float* W, int K, int N, bf16_t* WT, int mode, LAS float* scr, int item, int lane) {
    const int nblk = N / 32, kb = item / nblk, nb = item % nblk, k0 = 64 * kb, n0 = 32 * nb;
#pragma unroll 8
    for (int i = 0; i < 32; ++i) { const int kk = 2 * i + (lane >> 5); scr[kk * 33 + (lane & 31)] = W[(size_t)(k0 + kk) * N + n0 + (lane & 31)]; }
    asm volatile("s_waitcnt lgkmcnt(0)" ::: "memory");
    const int orow0 = (mode == 0) ? n0 : ((n0 >> 7) * 256 + (n0 & 127) + (mode == 2 ? 128 : 0));
    const int c = lane & 7;
#pragma unroll
    for (int j = 0; j < 4; ++j) { const int n = (lane >> 3) + 8 * j; const LAS float* s = scr + (8 * c) * 33 + n;
        u32x4 o; o.x = pk2(s[0 * 33], s[1 * 33]); o.y = pk2(s[2 * 33], s[3 * 33]); o.z = pk2(s[4 * 33], s[5 * 33]); o.w = pk2(s[6 * 33], s[7 * 33]);
        *(u32x4*)(WT + (size_t)(orow0 + n) * K + k0 + 8 * c) = o; }
    asm volatile("s_waitcnt lgkmcnt(0)" ::: "memory");
}

__device__ __forceinline__ void norm_pass(const Ctx& C0, int mode, const float* xp, const float* xs, const float* Fb, const float* Pb, int nsplit, const float* gpost, float alpha,
                                          float* H, const float* gnext, bf16_t* XN, const float* gkv, bf16_t* XN2, float* yout) {
    Ctx C = C0; asm volatile("" : "+v"(C.lane));
    for (int m = C.gw; m < M; m += C.NGW) {
        const size_t ro = (size_t)m * D + 4 * C.lane;
        f32x4 h[4];
        if (mode == 0) {
            const float* src = (m < MP) ? xp + ro : xs + (ro - (size_t)MP * D);
#pragma unroll
            for (int j = 0; j < 4; ++j) h[j] = *(const f32x4*)(src + 256 * j);
        } else {
            f32x4 f[4];
            if (m < MP) {
#pragma unroll
                for (int j = 0; j < 4; ++j) f[j] = *(const f32x4*)(Fb + ro + 256 * j);
            } else {
                const float* p = Pb + (size_t)(m - MP) * D + 4 * C.lane;
#pragma unroll
                for (int j = 0; j < 4; ++j) f[j] = *(const f32x4*)(p + 256 * j);
                for (int s = 1; s < nsplit; ++s) {
#pragma unroll
                    for (int j = 0; j < 4; ++j) f[j] += *(const f32x4*)(p + (size_t)s * MS * D + 256 * j);
                }
            }
            float ss = 0.f;
#pragma unroll
            for (int j = 0; j < 4; ++j) ss += ss4(f[j]);
            const float rf = alpha * __builtin_amdgcn_rsqf(wave_sum(ss, C.lane) * (1.0f / D) + EPS);
#pragma unroll
            for (int j = 0; j < 4; ++j) { const f32x4 g = *(const f32x4*)(gpost + 4 * C.lane + 256 * j); const f32x4 ho = *(const f32x4*)(H + ro + 256 * j); h[j] = ho + f[j] * rf * g; }
        }
        float ss = 0.f;
#pragma unroll
        for (int j = 0; j < 4; ++j) ss += ss4(h[j]);
        const float rh = __builtin_amdgcn_rsqf(wave_sum(ss, C.lane) * (1.0f / D) + EPS);
        if (yout) {
            float* yo = (m < MP) ? yout + O_YP + ro : yout + O_YS + (ro - (size_t)MP * D);
#pragma unroll
            for (int j = 0; j < 4; ++j) *(f32x4*)(yo + 256 * j) = h[j];
        } else {
#pragma unroll
            for (int j = 0; j < 4; ++j) *(f32x4*)(H + ro + 256 * j) = h[j];
#pragma unroll
            for (int j = 0; j < 4; ++j) { const f32x4 g = *(const f32x4*)(gnext + 4 * C.lane + 256 * j); const f32x4 v = h[j] * rh * g;
                u32x2 w; w.x = pk2(v.x, v.y); w.y = pk2(v.z, v.w); *(u32x2*)(XN + ro + 256 * j) = w; }
            if (gkv) {
#pragma unroll
                for (int j = 0; j < 4; ++j) { const f32x4 g = *(const f32x4*)(gkv + 4 * C.lane + 256 * j); const f32x4 v = h[j] * rh * g;
                    u32x2 w; w.x = pk2(v.x, v.y); w.y = pk2(v.z, v.w); *(u32x2*)(XN2 + ro + 256 * j) = w; }
            }
        }
    }
}

__device__ __forceinline__ void pool_pass(const Ctx& C0, int layer, const float* Fb, const float* Pb, int nsplit, const float* state, bf16_t* Z, float* out) {
    Ctx C = C0; asm volatile("" : "+v"(C.lane));
    const int NIT = NB * 64 * 4 + DB * 4;
    for (int it = C.gw; it < NIT; it += C.NGW) {
        if (it < NB * 64 * 4) {
            const int cgp = it & 3, chunk = (it >> 2) & 63, b = it >> 8, w = 2 << cgp, col = cgp * 256 + 4 * C.lane, t0 = chunk * 32;
            const float* U = Fb + (size_t)b * SEQ * D + col; bf16_t* Zb = Z + (size_t)b * SEQ * D + col;
            float* po = out + O_PP + ((size_t)(layer * NB + b) * 15) * D + col;
            f32x4 s = {0.f, 0.f, 0.f, 0.f};
            for (int j = 1; j < w; ++j) { const int t = t0 - j; if (t >= 0) s += *(const f32x4*)(U + (size_t)t * D); }
            for (int t = t0; t < t0 + 32; ++t) {
                const f32x4 ut = *(const f32x4*)(U + (size_t)t * D);
                s += ut;
                const float rc = 1.0f / (float)((t + 1 < w) ? (t + 1) : w);
                const f32x4 z = s * rc - ut;
                u32x2 o; o.x = pk2(z.x, z.y); o.y = pk2(z.z, z.w); *(u32x2*)(Zb + (size_t)t * D) = o;
                const int tp = t - w + 1; if (tp >= 0) s -= *(const f32x4*)(U + (size_t)tp * D);
                if (t >= SEQ - 15) *(f32x4*)(po + (size_t)(t - (SEQ - 15)) * D) = ut;
            }
        } else {
            const int r = it - NB * 64 * 4, cgp = r & 3, b = r >> 2, w = 2 << cgp, col = cgp * 256 + 4 * C.lane;
            f32x4 ext[23];
            const float* st = state + ((size_t)(layer * DB + b) * 15) * D + col;
#pragma unroll
            for (int e = 0; e < 15; ++e) ext[e] = *(const f32x4*)(st + (size_t)e * D);
#pragma unroll
            for (int t = 0; t < 8; ++t) {
                const float* p = Pb + (size_t)(b * 8 + t) * D + col; f32x4 a = *(const f32x4*)p;
                for (int s = 1; s < nsplit; ++s) a += *(const f32x4*)(p + (size_t)s * MS * D);
                ext[15 + t] = a;
            }
            bf16_t* Zb = Z + ((size_t)MP + b * 8) * D + col; float* po = out + O_PS + ((size_t)(layer * DB + b) * 15) * D + col;
            const float rc = 1.0f / (float)w;
#pragma unroll
            for (int t = 0; t < 8; ++t) {
                f32x4 s = {0.f, 0.f, 0.f, 0.f};
#pragma unroll
                for (int j = 0; j < 16; ++j) if (j < w) s += ext[15 + t - j];
                const f32x4 z = s * rc - ext[15 + t];
                u32x2 o; o.x = pk2(z.x, z.y); o.y = pk2(z.z, z.w); *(u32x2*)(Zb + (size_t)t * D) = o;
            }
#pragma unroll
            for (int i = 0; i < 15; ++i) *(f32x4*)(po + (size_t)i * D) = ext[8 + i];
        }
    }
}

#define MFMA32(a, b, c) __builtin_amdgcn_mfma_f32_32x32x16_bf16((a), (b), (c), 0, 0, 0)
constexpr int VROW = 192;
constexpr int NT_P = NB * NH * 3 * 64, NT_S = DB * NH * 13, NT_ALL = NT_P + NT_S;
__device__ __forceinline__ void attn_phase(const Ctx& C, int bx, LAS unsigned char* lds, const bf16_t* Q, const bf16_t* KB, const bf16_t* VB, const bf16_t* KBS, const bf16_t* VBS, bf16_t* OG, float* LSE) {
    LAS unsigned char* wl = lds + C.wave * (32 * VROW);
    int lane = C.lane; asm volatile("" : "+v"(lane));
    const int rr = lane & 31, hh = lane >> 5;
    const int trq = (lane & 15) >> 2, trp = lane & 3, trblk = (lane >> 4) & 1;
    const int nchunk = (NT_ALL + 7) / 8;
    for (int ch = bx; ch < nchunk; ch += C.G) {
        const int T = ch * 8 + C.wave;
        if (T >= NT_ALL) break;
        int b, h, g, r, i0, seqlen, qlo, qhi, mbase; const bf16_t *Kb, *Vb;
        if (T < NT_P) {
            const int blk = T & 63; int x = T >> 6; g = x % 3; x /= 3; h = x & 15; b = x >> 4;
            const int sh_ = 2 * g, nbs = 64 >> sh_; r = blk / nbs; i0 = (blk % nbs) * 32;
            seqlen = SEQ; qlo = 0; qhi = SEQ; mbase = b * SEQ; Kb = KB + (size_t)b * SEQ * D; Vb = VB + (size_t)b * SEQ * D;
        } else {
            int x = T - NT_P; const int k = x % 13; x /= 13; h = x & 15; b = x >> 4;
            if (k == 0) { g = 0; r = 0; i0 = 2048; } else if (k < 5) { g = 1; r = k - 1; i0 = 512; } else { g = 2; r = k - 5; i0 = 128; }
            seqlen = SROWS; qlo = KVB; qhi = SROWS; mbase = MP + b * DT; Kb = KBS + (size_t)b * SROWS * D; Vb = VBS + (size_t)b * SROWS * D;
        }
        const int sh = 2 * g;
        const float slope_d = __builtin_amdgcn_exp2f(-0.5f * (float)(h + 1)) * (float)(1 << sh);
        const int pq = r + ((i0 + rr) << sh);
        const bool qvalid = (pq >= qlo) && (pq < qhi);
        const int pqc = pq < qlo ? qlo : (pq >= qhi ? qhi - 1 : pq);
        const int mrow = mbase + pqc - qlo;
        const bf16_t* qp = Q + (size_t)mrow * NQ + g * D + h * HD + 8 * hh;
        bf16x8 qf[4];
#pragma unroll
        for (int s = 0; s < 4; ++s) qf[s] = *(const bf16x8*)(qp + 16 * s);
        unsigned koff[5];
#pragma unroll
        for (int kb = 0; kb < 5; ++kb) { const int kidx = i0 - 128 + 32 * kb + rr; int pk = r + kidx * (1 << sh); pk = pk < 0 ? 0 : (pk >= seqlen ? seqlen - 1 : pk); koff[kb] = (unsigned)(pk * D + h * HD + 8 * hh); }
        float p[5][16];
        float mx = -3.0e38f;
#pragma unroll
        for (int kb = 0; kb < 5; ++kb) {
            bf16x8 kf[4];
#pragma unroll
            for (int s = 0; s < 4; ++s) kf[s] = *(const bf16x8*)(Kb + koff[kb] + 16 * s);
            f32x16 a;
#pragma unroll
            for (int i = 0; i < 16; ++i) a[i] = 0.f;
#pragma unroll
            for (int s = 0; s < 4; ++s) a = MFMA32(kf[s], qf[s], a);
#pragma unroll
            for (int i = 0; i < 16; ++i) {
                const int kk = 32 * kb + (i & 3) + 8 * (i >> 2) + 4 * hh, step = rr + 128 - kk;
                const bool valid = (step >= 0) && (step <= 128) && (i0 - 128 + kk >= 0);
                const float v = valid ? a[i] - slope_d * (float)step : -1.0e30f;
                p[kb][i] = v; mx = fmaxf(mx, v);
            }
            __builtin_amdgcn_sched_barrier(0);
        }
        mx = fmaxf(mx, lane_xor(mx, lane, 32));
        float l = 0.f;
        f32x16 o[2];
#pragma unroll
        for (int i = 0; i < 16; ++i) { o[0][i] = 0.f; o[1][i] = 0.f; }
        bf16x8 vn[4];
#pragma unroll
        for (int s = 0; s < 4; ++s) vn[s] = *(const bf16x8*)(Vb + koff[0] + 16 * s);
#pragma unroll
        for (int kb = 0; kb < 5; ++kb) {
#pragma unroll
            for (int s = 0; s < 4; ++s) *(LAS bf16x8*)(wl + rr * VROW + 32 * s + 16 * hh) = vn[s];
            if (kb < 4) {
#pragma unroll
                for (int s = 0; s < 4; ++s) vn[s] = *(const bf16x8*)(Vb + koff[kb < 4 ? kb + 1 : 4] + 16 * s);
            }
#pragma unroll
            for (int i = 0; i < 16; ++i) { const float e = __expf(p[kb][i] - mx); p[kb][i] = e; l += e; }
#pragma unroll
            for (int s2 = 0; s2 < 2; ++s2) {
                u32x4 pw;
                pw.x = pk2(p[kb][8 * s2 + 0], p[kb][8 * s2 + 1]); pw.y = pk2(p[kb][8 * s2 + 2], p[kb][8 * s2 + 3]);
                pw.z = pk2(p[kb][8 * s2 + 4], p[kb][8 * s2 + 5]); pw.w = pk2(p[kb][8 * s2 + 6], p[kb][8 * s2 + 7]);
                const bf16x8 pf = __builtin_bit_cast(bf16x8, pw);
#pragma unroll
                for (int nb = 0; nb < 2; ++nb) {
                    const s16x4 lo = __builtin_amdgcn_ds_read_tr16_b64_v4i16((LAS s16x4*)(wl + (16 * s2 + 4 * hh + trq) * VROW + 64 * nb + 32 * trblk + 8 * trp));
                    const s16x4 hi = __builtin_amdgcn_ds_read_tr16_b64_v4i16((LAS s16x4*)(wl + (16 * s2 + 8 + 4 * hh + trq) * VROW + 64 * nb + 32 * trblk + 8 * trp));
                    const bf16x8 vt = __builtin_shufflevector(lo, hi, 0, 1, 2, 3, 4, 5, 6, 7);
                    o[nb] = MFMA32(vt, pf, o[nb]);
                }
            }
            __builtin_amdgcn_sched_barrier(0);
        }
        l += lane_xor(l, lane, 32);
        const float inv = 1.0f / l;
        if (qvalid) {
            bf16_t* op = OG + ((size_t)g * M + mrow) * D + h * HD + 4 * hh;
#pragma unroll
            for (int nb = 0; nb < 2; ++nb)
#pragma unroll
                for (int q4 = 0; q4 < 4; ++q4) { u32x2 w; w.x = pk2(o[nb][4 * q4] * inv, o[nb][4 * q4 + 1] * inv); w.y = pk2(o[nb][4 * q4 + 2] * inv, o[nb][4 * q4 + 3] * inv);
                    *(u32x2*)(op + 32 * nb + 8 * q4) = w; }
            if (hh == 0) LSE[((size_t)g * M + mrow) * NH + h] = mx + __logf(l);
        }
    }
}

__device__ __forceinline__ void combine_pass(const Ctx& C0, const bf16_t* OG, const float* LSE, bf16_t* O) {
    Ctx C = C0; asm volatile("" : "+v"(C.lane));
    for (int m = C.gw; m < M; m += C.NGW) {
        const int head = C.lane >> 2;
        const float l0 = LSE[((size_t)0 * M + m) * NH + head], l1 = LSE[((size_t)1 * M + m) * NH + head], l2 = LSE[((size_t)2 * M + m) * NH + head];
        const float mx = fmaxf(l0, fmaxf(l1, l2));
        float w0 = __expf(l0 - mx), w1 = __expf(l1 - mx), w2 = __expf(l2 - mx);
        const float inv = 1.0f / (w0 + w1 + w2); w0 *= inv; w1 *= inv; w2 *= inv;
        const size_t off = (size_t)m * D + 16 * C.lane;
#pragma unroll
        for (int hf = 0; hf < 2; ++hf) {
            const u32x4 a = *(const u32x4*)(OG + off + 8 * hf), b = *(const u32x4*)(OG + (size_t)M * D + off + 8 * hf), c = *(const u32x4*)(OG + 2 * (size_t)M * D + off + 8 * hf);
            u32x4 w;
#pragma unroll
            for (int e = 0; e < 4; ++e) w[e] = pk2(w0 * bf_lo(a[e]) + w1 * bf_lo(b[e]) + w2 * bf_lo(c[e]), w0 * bf_hi(a[e]) + w1 * bf_hi(b[e]) + w2 * bf_hi(c[e]));
            *(u32x4*)(O + off + 8 * hf) = w;
        }
    }
}

constexpr int SLOTS = 12, NPH = 1 + 4 * SLOTS;
__global__ void __launch_bounds__(NWAVES * 64, 2) yoco_fwd(Args args) {
    extern __shared__ __attribute__((aligned(16))) unsigned char lds_raw[];
    LAS unsigned char* lds = (LAS unsigned char*)lds_raw;
#if MK_ONE_LAUNCH
    cg::grid_group grid = cg::this_grid();
#endif
    for (int ph = args.ph_lo; ph < args.ph_hi; ++ph) {
        bool did = true;
        unsigned char* ws = args.ws; float* out = args.out; int tid_ = threadIdx.x, bx_ = blockIdx.x;
        asm volatile("" : "+s"(ws), "+s"(out), "+v"(tid_), "+s"(bx_));
        Ctx C; C.lane = tid_ & 63; C.wave = __builtin_amdgcn_readfirstlane(tid_ >> 6); C.G = gridDim.x;
        { const int vcu = (C.G % 8 == 0) ? (bx_ % 8) * (C.G / 8) + bx_ / 8 : bx_; C.gw = vcu * NWAVES + C.wave; C.NGW = C.G * NWAVES; }
        const float *x_p = args.in[0], *x_s = args.in[1], *state = args.in[2], *cache_k = args.in[3], *cache_v = args.in[4], *norm_g = args.in[5];
        const float *w_gate = args.in[6], *w_up = args.in[7], *w_down = args.in[8], *p_win = args.in[9], *p_wgrp = args.in[10], *p_scale = args.in[11], *p_wout = args.in[12];
        const float *kv_norm = args.in[13], *w_k = args.in[14], *w_v = args.in[15], *a_wq = args.in[16], *a_wo = args.in[17];
        float* H = (float*)(ws + WS_H); bf16_t* XN = (bf16_t*)(ws + WS_XN); bf16_t* XN2 = (bf16_t*)(ws + WS_XN2); bf16_t* ACT = (bf16_t*)(ws + WS_ACT);
        float* Fb = (float*)(ws + WS_F); float* Pb = (float*)(ws + WS_PART); bf16_t* OG = (bf16_t*)(ws + WS_OG); float* LSE = (float*)(ws + WS_LSE);
        bf16_t *KB = (bf16_t*)(ws + WS_KB), *VB = (bf16_t*)(ws + WS_VB), *KBS = (bf16_t*)(ws + WS_KBS), *VBS = (bf16_t*)(ws + WS_VBS);
        if (ph == 0) {
            LAS float* scr = (LAS float*)(lds + C.wave * 16384);
            constexpr int I_FFN = 24 * 1408, I_SQ = 6 * 512, I_Q = 2 * 1536, NITEMS = I_FFN + I_SQ + I_Q;
            for (int it = C.gw; it < NITEMS; it += C.NGW) {
                int r = it;
                if (r < I_FFN) { const int job = r / 1408, item = r % 1408, li = job / 3, kind = job % 3;
                    bf16_t* dst = (bf16_t*)(ws + WS_FFN + (size_t)li * FFN_STRIDE);
                    if (kind == 0) tr_item(w_gate + (size_t)li * D * FF, D, FF, dst, 1, scr, item, C.lane);
                    else if (kind == 1) tr_item(w_up + (size_t)li * D * FF, D, FF, dst, 2, scr, item, C.lane);
                    else tr_item(w_down + (size_t)li * D * FF, FF, D, (bf16_t*)((unsigned char*)dst + WD_OFF), 0, scr, item, C.lane);
                    continue; }
                r -= I_FFN;
                if (r < I_SQ) { const int job = r / 512, item = r % 512; const float* src; bf16_t* dst;
                    if (job < 2) { src = p_win + (size_t)job * D * D; dst = (bf16_t*)(ws + WS_WIN) + (size_t)job * D * D; }
                    else if (job == 2) { src = w_k; dst = (bf16_t*)(ws + WS_WKV); }
                    else if (job == 3) { src = w_v; dst = (bf16_t*)(ws + WS_WKV) + (size_t)D * D; }
                    else { src = a_wo + (size_t)(job - 4) * D * D; dst = (bf16_t*)(ws + WS_WO) + (size_t)(job - 4) * D * D; }
                    tr_item(src, D, D, dst, 0, scr, item, C.lane); continue; }
                r -= I_SQ;
                { const int job = r / 1536, item = r % 1536; tr_item(a_wq + (size_t)job * D * NQ, D, NQ, (bf16_t*)(ws + WS_WQ) + (size_t)job * NQ * D, 0, scr, item, C.lane); }
            }
            for (int it = C.gw; it < 2 * 16 * 128; it += C.NGW) {
                const int kb = it & 127, nbk = (it >> 7) & 15, ly = it >> 11, k0 = kb * 8, g = k0 >> 8, n = nbk * 64 + C.lane;
                const float* G = p_wgrp + ((size_t)(ly * 4 + g) * 256 + (k0 & 255)) * 256;
                const float* S = p_scale + ly * D + g * 256; const float* WO = p_wout + ((size_t)ly * D + g * 256) * D + n;
                float a[8];
#pragma unroll
                for (int q = 0; q < 8; ++q) a[q] = 0.f;
                for (int j = 0; j < 256; ++j) { const float sv = S[j] * WO[(size_t)j * D];
#pragma unroll
                    for (int q = 0; q < 8; ++q) a[q] += G[q * 256 + j] * sv; }
                u32x4 o; o.x = pk2(a[0], a[1]); o.y = pk2(a[2], a[3]); o.z = pk2(a[4], a[5]); o.w = pk2(a[6], a[7]);
                *(u32x4*)((bf16_t*)(ws + WS_WEFF) + ((size_t)ly * D + n) * D + k0) = o;
            }
            for (int it = C.gw; it < 2 * DB * KVB; it += C.NGW) {
                const int j = it & (KVB - 1), b = (it >> 11) & 31, kv = it >> 16;
                const float* src = (kv ? cache_v : cache_k) + ((size_t)b * KVB + j) * D + 4 * C.lane;
                float* dst = out + (kv ? O_VS : O_KS) + ((size_t)b * KVB + (j - DT)) * D + 4 * C.lane;
                bf16_t* bd = (kv ? VBS : KBS) + ((size_t)b * SROWS + j) * D + 4 * C.lane;
#pragma unroll
                for (int q = 0; q < 4; ++q) { const f32x4 v = __builtin_nontemporal_load((const f32x4*)(src + 256 * q));
                    if (j >= DT) __builtin_nontemporal_store(v, (f32x4*)(dst + 256 * q));
                    u32x2 w; w.x = pk2(v.x, v.y); w.y = pk2(v.z, v.w); *(u32x2*)(bd + 256 * q) = w; }
            }
            norm_pass(C, 0, x_p, x_s, nullptr, nullptr, 1, nullptr, 0.f, H, norm_g, XN, nullptr, nullptr, nullptr);
        } else {
            const int l = (ph - 1) / SLOTS, slot = (ph - 1) % SLOTS;
            const bool pool = l < 2; const int j = l - 2;
            const float* gl = norm_g + (size_t)l * 6 * D;
            int gt = -1; const bf16_t* gA = nullptr; const bf16_t* gB = nullptr; int gN = 0, gK = 0, gS = 1;
            switch (slot) {
                case 0: if (l == 2) { gt = 3; gA = XN2; gB = (const bf16_t*)(ws + WS_WKV); gN = 2 * D; gK = D; } else did = false; break;
                case 1: case 9: { const int li = l * 2 + (slot == 9); gt = 0; gA = XN; gB = (const bf16_t*)(ws + WS_FFN + (size_t)li * FFN_STRIDE); gN = 2 * FF; gK = D; } break;
                case 2: case 10: { const int li = l * 2 + (slot == 10); gt = 1; gA = ACT; gB = (const bf16_t*)(ws + WS_FFN + (size_t)li * FFN_STRIDE + WD_OFF); gN = D; gK = FF; gS = 22; } break;
                case 3: norm_pass(C, 1, nullptr, nullptr, Fb, Pb, 22, gl + D, 0.5f, H, gl + 2 * D, XN, nullptr, nullptr, nullptr); break;
                case 4: if (pool) { gt = 1; gA = XN; gB = (const bf16_t*)(ws + WS_WIN) + (size_t)l * D * D; gN = D; gK = D; gS = 8; }
                        else { gt = 2; gA = XN; gB = (const bf16_t*)(ws + WS_WQ) + (size_t)j * NQ * D; gN = NQ; gK = D; } break;
                case 5: if (pool) pool_pass(C, l, Fb, Pb, 8, state, XN2, out); else attn_phase(C, bx_, lds, ACT, KB, VB, KBS, VBS, OG, LSE); break;
                case 6: if (!pool) combine_pass(C, OG, LSE, XN2); else did = false; break;
                case 7: gt = 1; gA = XN2; gB = pool ? (const bf16_t*)(ws + WS_WEFF) + (size_t)l * D * D : (const bf16_t*)(ws + WS_WO) + (size_t)j * D * D; gN = D; gK = D; gS = 8; break;
                case 8: norm_pass(C, 1, nullptr, nullptr, Fb, Pb, 8, gl + 3 * D, 1.0f, H, gl + 4 * D, XN, nullptr, nullptr, nullptr); break;
                case 11: norm_pass(C, 1, nullptr, nullptr, Fb, Pb, 22, gl + 5 * D, 0.5f, H, (l < 3) ? gl + 6 * D : gl, XN, (l == 1) ? kv_norm : nullptr, XN2, (l == 3) ? out : nullptr); break;
                default: break;
            }
            if (gt >= 0) {
                pg8::Sched S; S.init(gA, gB, gN, gK, gS, C.G, bx_);
                if (gt == 0) { pg8::EpiSwiglu E{ACT}; pg8::gemm_phase(lds, S, E, tid_); }
                else if (gt == 1) { pg8::EpiF32 E{Fb, Pb}; pg8::gemm_phase(lds, S, E, tid_); }
                else if (gt == 2) { pg8::EpiQ E{ACT, 0.125f}; pg8::gemm_phase(lds, S, E, tid_); }
                else { pg8::EpiKV E{out + O_KP, out + O_VP, out + O_KS, out + O_VS, KB, VB, KBS, VBS}; pg8::gemm_phase(lds, S, E, tid_); }
            }
        }
#if MK_ONE_LAUNCH
        if (did && ph + 1 < args.ph_hi) grid.sync();
#endif
    }
}

extern "C" void kernel_launch(void* const* d_in, const int* in_sizes, int n_in, void* d_out, int out_size, void* d_ws, size_t ws_size, hipStream_t stream) {
    static int grid = 0;
    if (grid == 0) {
        if (n_in != 18 || ws_size < WS_END) { fprintf(stderr, "kernel_launch: unexpected inputs (n_in %d, ws %zu < %zu)\n", n_in, ws_size, (size_t)WS_END); grid = -1; return; }
        int dev = 0, cus = 0;
        if (hipGetDevice(&dev) != hipSuccess || hipDeviceGetAttribute(&cus, hipDeviceAttributeMultiprocessorCount, dev) != hipSuccess) { grid = -1; return; }
        if (hipFuncSetAttribute((const void*)yoco_fwd, hipFuncAttributeMaxDynamicSharedMemorySize, LDS_BYTES) != hipSuccess) { fprintf(stderr, "kernel_launch: hipFuncSetAttribute failed\n"); grid = -1; return; }
        int per_cu = 0;
        if (hipOccupancyMaxActiveBlocksPerMultiprocessor(&per_cu, (const void*)yoco_fwd, NWAVES * 64, LDS_BYTES) != hipSuccess || per_cu < 1) { fprintf(stderr, "kernel_launch: occupancy query says %d\n", per_cu); per_cu = 1; }
        (void)hipGetLastError();
        grid = cus;
    }
    if (grid < 0) return;
    Args a{};
    for (int i = 0; i < 18; ++i) a.in[i] = (const float*)d_in[i];
    a.out = (float*)d_out; a.ws = (unsigned char*)d_ws;
#if MK_ONE_LAUNCH
    a.ph_lo = 0; a.ph_hi = NPH;
    void* kargs[] = {&a};
    hipError_t e = hipLaunchCooperativeKernel((const void*)yoco_fwd, dim3(grid), dim3(NWAVES * 64), kargs, LDS_BYTES, stream);
    if (e != hipSuccess) fprintf(stderr, "kernel_launch: cooperative launch failed: %s (grid %d)\n", hipGetErrorString(e), grid);
#else
    for (int ph = 0; ph < NPH; ++ph) {
        if (ph > 0) { const int l = (ph - 1) / SLOTS, slot = (ph - 1) % SLOTS; if ((slot == 0 && l != 2) || (slot == 6 && l < 2)) continue; }
        a.ph_lo = ph; a.ph_hi = ph + 1;
        hipLaunchKernelGGL(yoco_fwd, dim3(grid), dim3(NWAVES * 64), LDS_BYTES, stream, a);
    }
#endif
}
```

```cpp
#include <hip/hip_runtime.h>
#include <hip/hip_cooperative_groups.h>
#include <cstdio>
#include <cstdint>
namespace cg = cooperative_groups;

#ifndef REP_GEMM
#define REP_GEMM 1
#endif
#ifndef REP_ATTN
#define REP_ATTN 1
#endif
#ifndef REP_PRO
#define REP_PRO 1
#endif
#ifndef PROBE_SLOT
#define PROBE_SLOT -1
#endif
#ifndef PROBE_LMIN
#define PROBE_LMIN 0
#endif
#ifndef PROBE_LMAX
#define PROBE_LMAX 3
#endif
#ifndef PROBE_AMODE
#define PROBE_AMODE 3
#endif
#ifndef MK_ONE_LAUNCH
#define MK_ONE_LAUNCH 1
#endif

#define LAS __attribute__((address_space(3)))
typedef unsigned short bf16_t;
typedef short bf16x8 __attribute__((ext_vector_type(8)));
typedef short s16x4 __attribute__((ext_vector_type(4)));
typedef float f32x4 __attribute__((ext_vector_type(4)));
typedef float f32x2 __attribute__((ext_vector_type(2)));
typedef float f32x16 __attribute__((ext_vector_type(16)));
typedef unsigned u32x4 __attribute__((ext_vector_type(4)));
typedef unsigned u32x2 __attribute__((ext_vector_type(2)));
typedef __bf16 bf16v2 __attribute__((ext_vector_type(2)));

__device__ __forceinline__ unsigned pk2(float lo, float hi) { f32x2 v = {lo, hi}; bf16v2 r = __builtin_convertvector(v, bf16v2); return __builtin_bit_cast(unsigned, r); }
__device__ __forceinline__ float bf_lo(unsigned w) { return __uint_as_float(w << 16); }
__device__ __forceinline__ float bf_hi(unsigned w) { return __uint_as_float(w & 0xffff0000u); }
__device__ __forceinline__ f32x4 ld_bf4(const bf16_t* p) { const u32x2 w = *(const u32x2*)p; return (f32x4){bf_lo(w.x), bf_hi(w.x), bf_lo(w.y), bf_hi(w.y)}; }
__device__ __forceinline__ void st_bf4(bf16_t* p, const f32x4 v) { u32x2 w; w.x = pk2(v.x, v.y); w.y = pk2(v.z, v.w); *(u32x2*)p = w; }

constexpr int D = 1024, FF = 2816, MP = 16384, MS = 256, M = MP + MS, SEQ = 2048, NB = 8, DB = 32, DT = 8, KVB = 2048, SROWS = KVB + DT;
constexpr int NH = 16, HD = 64, NQ = 3 * D;
constexpr float EPS = 1e-6f;
constexpr size_t O_YP = 0, O_YS = 16777216, O_PP = 17039360, O_KP = 17285120, O_VP = 34062336, O_PS = 50839552, O_KS = 51822592, O_VS = 118931456;
constexpr size_t MiB = 1u << 20;
constexpr size_t WS_FFN = 1 * MiB;
constexpr size_t FFN_STRIDE = 17301504, WD_OFF = 11534336;
constexpr size_t WS_WIN = 133 * MiB, WS_WEFF = 137 * MiB, WS_WKV = 141 * MiB, WS_WQ = 145 * MiB, WS_WO = 157 * MiB;
constexpr size_t WS_H = 161 * MiB;
constexpr size_t WS_XN = 226 * MiB;
constexpr size_t WS_XN2 = WS_XN + 34078720;
constexpr size_t WS_ACT = 291 * MiB;
constexpr size_t WS_F = WS_ACT + 102236160;
constexpr size_t WS_PART = WS_F + 68157440;
constexpr size_t WS_OG = WS_PART + 22 * MiB + MiB / 2;
constexpr size_t WS_LSE = WS_OG + 102236160;
constexpr size_t WS_KB = 577 * MiB, WS_VB = 609 * MiB;
constexpr size_t WS_KBS = 641 * MiB;
constexpr size_t WS_VBS = WS_KBS + 134742016;
constexpr size_t WS_END = WS_VBS + 134742016;
static_assert(WS_LSE + 3 * (size_t)M * 16 * 4 <= WS_KB, "ws map");

constexpr int LDS_BYTES = 147456;
constexpr int NWAVES = 8;

namespace pg8 {
constexpr int BM = 256, BK = 64, HALF = 128, HTB = HALF * BK * 2, STAGE_BYTES = 8 * HTB;
__device__ __forceinline__ int lds_byte(int r, int c) { const int st = (r >> 4) * 2 + (c >> 5), rr = r & 15, cc = c & 31, ob = rr * 64 + cc * 2; return st * 1024 + (ob ^ (((ob >> 9) & 1) << 5)); }
__device__ __forceinline__ void stage_rc(int b, int& R, int& C) { const int st = b / 1024, sb = b % 1024, swz = sb ^ (((sb >> 9) & 1) << 5); R = (st >> 1) * 16 + swz / 64; C = (st & 1) * 32 + (swz % 64) / 2; }
__device__ __forceinline__ int perm32(int rho) { const int n = rho >> 4, i = rho & 15; return 8 * (i >> 2) + 4 * n + (i & 3); }

struct Unit { const char* A; const char* B; int nt, pm, pn, ks; };

struct Sched {
    const char* A; const char* Bt; int ld, nN, nwgP, G, c, nsplit, ntf;
    __device__ __forceinline__ void init(const bf16_t* A_, const bf16_t* Bt_, int N, int K, int nsplit_, int G_, int c_) {
        A = (const char*)A_; Bt = (const char*)Bt_; ld = K; nN = N / BM; nwgP = 64 * nN; G = G_; c = c_; nsplit = nsplit_; ntf = K / BK; }
    int sfirst = 0;
    __device__ __forceinline__ bool next(int i, Unit& u) const {
        long L = (long)i * G + c; const size_t tstep = (size_t)BM * ld * 2;
        if (sfirst) { const bool hasS = c < nN * nsplit; if (i > (hasS ? 1 : 0)) return false; L = (hasS && i == 0) ? (long)nwgP + c : (long)c; }
        if (L < nwgP) {
            int wgid = (int)L; { const int q = nwgP / 8, xcd = wgid % 8, off = wgid / 8; wgid = xcd * q + off; }
            const int nig = 8 * nN, gid = wgid / nig, fm = gid * 8;
            u.pm = fm + ((wgid % nig) % 8); u.pn = (wgid % nig) / 8; u.ks = 0; u.nt = ntf;
            u.A = A + (size_t)u.pm * tstep; u.B = Bt + (size_t)u.pn * tstep; return true;
        }
        L -= nwgP; if (L >= (long)nN * nsplit) return false;
        u.pm = 64; u.pn = (int)(L % nN); u.ks = (int)(L / nN); u.nt = ntf / nsplit;
        const size_t koff = (size_t)u.ks * u.nt * (BK * 2);
        u.A = A + 64 * tstep + koff; u.B = Bt + (size_t)u.pn * tstep + koff; return true;
    }
};

__device__ __forceinline__ float silu_mul(float g, float u) { return g * u * __builtin_amdgcn_rcpf(1.0f + __expf(-g)); }

struct EpiSwiglu {
    static constexpr bool PERM = true, AFTER_DRAIN = false;
    bf16_t* O; const float* R;
    __device__ __forceinline__ void operator()(const f32x4 (&acc)[2][2][4][2], const Unit& u, int wr, int wc, int fr, int fq) const {
        asm volatile("" : "+v"(fr), "+v"(fq));
        const int col0 = u.pn * HALF + wc * 32 + 8 * fq;
#pragma unroll
        for (int ai = 0; ai < 2; ++ai)
#pragma unroll
            for (int m = 0; m < 4; ++m) {
                const int grow = u.pm * BM + ai * HALF + wr * 64 + m * 16 + fr; const float rs = R[grow];
                bf16_t* rowp = O + (size_t)grow * FF + col0;
                const f32x4 g0 = acc[ai][0][m][0] * rs, g1 = acc[ai][0][m][1] * rs, u0 = acc[ai][1][m][0] * rs, u1 = acc[ai][1][m][1] * rs;
                u32x4 w;
                w.x = pk2(silu_mul(g0[0], u0[0]), silu_mul(g0[1], u0[1])); w.y = pk2(silu_mul(g0[2], u0[2]), silu_mul(g0[3], u0[3]));
                w.z = pk2(silu_mul(g1[0], u1[0]), silu_mul(g1[1], u1[1])); w.w = pk2(silu_mul(g1[2], u1[2]), silu_mul(g1[3], u1[3]));
                *(u32x4*)rowp = w;
            }
    }
};
struct EpiQ {
    static constexpr bool PERM = true, AFTER_DRAIN = false;
    bf16_t* O; float scale; const float* R;
    __device__ __forceinline__ void operator()(const f32x4 (&acc)[2][2][4][2], const Unit& u, int wr, int wc, int fr, int fq) const {
        asm volatile("" : "+v"(fr), "+v"(fq));
        const int col0 = u.pn * BM + wc * 32 + 8 * fq;
#pragma unroll
        for (int ai = 0; ai < 2; ++ai)
#pragma unroll
            for (int m = 0; m < 4; ++m) {
                const int grow = u.pm * BM + ai * HALF + wr * 64 + m * 16 + fr; const float rs = scale * R[grow];
                bf16_t* rowp = O + (size_t)grow * NQ + col0;
#pragma unroll
                for (int bj = 0; bj < 2; ++bj) { const f32x4 v0 = acc[ai][bj][m][0] * rs, v1 = acc[ai][bj][m][1] * rs;
                    u32x4 w; w.x = pk2(v0[0], v0[1]); w.y = pk2(v0[2], v0[3]); w.z = pk2(v1[0], v1[1]); w.w = pk2(v1[2], v1[3]);
                    *(u32x4*)(rowp + bj * HALF) = w; }
            }
    }
};
struct EpiF32 {
    static constexpr bool PERM = false, AFTER_DRAIN = false;
    float* F; float* P; const float* R;
    __device__ __forceinline__ void operator()(const f32x4 (&acc)[2][2][4][2], const Unit& u, int wr, int wc, int fr, int fq) const {
        asm volatile("" : "+v"(fr), "+v"(fq));
        float* base = (u.pm < 64) ? F + (size_t)u.pm * BM * D : P + (size_t)u.ks * BM * D;
        const int col0 = u.pn * BM + wc * 32 + 4 * fq;
#pragma unroll
        for (int ai = 0; ai < 2; ++ai)
#pragma unroll
            for (int m = 0; m < 4; ++m) {
                const int lrow = ai * HALF + wr * 64 + m * 16 + fr; const float rs = R ? R[u.pm * BM + lrow] : 1.0f;
                float* rowp = base + (size_t)lrow * D + col0;
#pragma unroll
                for (int bj = 0; bj < 2; ++bj)
#pragma unroll
                    for (int n = 0; n < 2; ++n) *(f32x4*)(rowp + bj * HALF + n * 16) = acc[ai][bj][m][n] * rs;
                asm volatile("" ::: "memory");
            }
    }
};
struct EpiU {
    static constexpr bool PERM = false, AFTER_DRAIN = false;
    bf16_t* U; float* P; const float* R; float* po;
    __device__ __forceinline__ void operator()(const f32x4 (&acc)[2][2][4][2], const Unit& u, int wr, int wc, int fr, int fq) const {
        asm volatile("" : "+v"(fr), "+v"(fq));
        const int col0 = u.pn * BM + wc * 32 + 4 * fq;
#pragma unroll
        for (int ai = 0; ai < 2; ++ai)
#pragma unroll
            for (int m = 0; m < 4; ++m) {
                const int lrow = ai * HALF + wr * 64 + m * 16 + fr, grow = u.pm * BM + lrow; const float rs = R[grow];
                if (u.pm < 64) {
                    bf16_t* rowp = U + (size_t)grow * D + col0; const int t = grow & (SEQ - 1);
                    float* sp = (t >= SEQ - 15) ? po + ((size_t)(grow >> 11) * 15 + (t - (SEQ - 15))) * D + col0 : nullptr;
#pragma unroll
                    for (int bj = 0; bj < 2; ++bj)
#pragma unroll
                        for (int n = 0; n < 2; ++n) { const f32x4 v = acc[ai][bj][m][n] * rs; u32x2 w; w.x = pk2(v[0], v[1]); w.y = pk2(v[2], v[3]); *(u32x2*)(rowp + bj * HALF + n * 16) = w;
                            if (sp) *(f32x4*)(sp + bj * HALF + n * 16) = v; }
                } else {
                    float* rowp = P + (size_t)u.ks * BM * D + (size_t)lrow * D + col0;
#pragma unroll
                    for (int bj = 0; bj < 2; ++bj)
#pragma unroll
                        for (int n = 0; n < 2; ++n) *(f32x4*)(rowp + bj * HALF + n * 16) = acc[ai][bj][m][n] * rs;
                }
                asm volatile("" ::: "memory");
            }
    }
};
struct EpiKV {
    static constexpr bool PERM = false, AFTER_DRAIN = false;
    float *oKp, *oVp, *oKs, *oVs; bf16_t *KB, *VB, *KBS, *VBS; const float* R;
    __device__ __forceinline__ void operator()(const f32x4 (&acc)[2][2][4][2], const Unit& u, int wr, int wc, int fr, int fq) const {
        asm volatile("" : "+v"(fr), "+v"(fq));
        const bool isV = u.pn >= 4; const int col0 = (u.pn & 3) * BM + wc * 32 + 4 * fq;
#pragma unroll
        for (int ai = 0; ai < 2; ++ai)
#pragma unroll
            for (int m = 0; m < 4; ++m) {
                const int lrow = ai * HALF + wr * 64 + m * 16 + fr; float* fo; bf16_t* bo; const float rs = R[u.pm * BM + lrow];
                if (u.pm < 64) { const size_t g = (size_t)(u.pm * BM + lrow) * D; fo = (isV ? oVp : oKp) + g; bo = (isV ? VB : KB) + g; }
                else { const int b = lrow >> 3, t = lrow & 7; fo = (isV ? oVs : oKs) + ((size_t)b * KVB + (KVB - DT) + t) * D; bo = (isV ? VBS : KBS) + ((size_t)b * SROWS + KVB + t) * D; }
#pragma unroll
                for (int bj = 0; bj < 2; ++bj)
#pragma unroll
                    for (int n = 0; n < 2; ++n) { const f32x4 v = acc[ai][bj][m][n] * rs; const int c = col0 + bj * HALF + n * 16;
                        *(f32x4*)(fo + c) = v; u32x2 w; w.x = pk2(v[0], v[1]); w.y = pk2(v[2], v[3]); *(u32x2*)(bo + c) = w; }
                asm volatile("" ::: "memory");
            }
    }
};

template <class Epi>
__device__ __forceinline__ void gemm_phase(LAS unsigned char* lds, const Sched& S, const Epi& E, int tid) {
    const int wid = __builtin_amdgcn_readfirstlane(tid >> 6), lane = tid & 63, wr = wid >> 2, wc = wid & 3, fr = lane & 15, fq = lane >> 4;
    const int ld = S.ld;
    unsigned voffA[2], voffB[2];
#pragma unroll
    for (int i = 0; i < 2; ++i) { int R, C; stage_rc(tid * 16 + i * 8192, R, C); const int Rb = Epi::PERM ? ((R & ~31) + perm32(R & 31)) : R;
        voffA[i] = (unsigned)(R * ld + C) * 2u; voffB[i] = (unsigned)(Rb * ld + C) * 2u; }
    const size_t kstep = (size_t)(BK * 2);
    const size_t hstep = (size_t)HALF * ld * 2;
    const unsigned ldsw = (unsigned)wid * 1024u;
    const int aoff = lds_byte(wr * 64 + fr, fq * 8), boff = lds_byte(wc * 32 + fr, fq * 8);
#define PG8_SA(b, h) (((b) * 2 + (h)) * HTB)
#define PG8_SB(b, h) ((4 + (b) * 2 + (h)) * HTB)
#define PG8_STAGE(bufoff, gbase, voff) do { _Pragma("unroll") for (int _i = 0; _i < 2; ++_i) \
        __builtin_amdgcn_global_load_lds((const unsigned*)((const char*)(gbase) + (voff)[_i]), (LAS unsigned*)(lds + (bufoff) + ldsw + _i * 8192), 16, 0, 0); } while (0)
#define PG8_LDA(dst, b, h) do { _Pragma("unroll") for (int m = 0; m < 4; ++m) _Pragma("unroll") for (int k = 0; k < 2; ++k) dst[m][k] = *(const LAS bf16x8*)(lds + PG8_SA(b, h) + aoff + m * 2048 + k * 1024); } while (0)
#define PG8_LDB(dst, b, h) do { _Pragma("unroll") for (int n = 0; n < 2; ++n) _Pragma("unroll") for (int k = 0; k < 2; ++k) dst[n][k] = *(const LAS bf16x8*)(lds + PG8_SB(b, h) + boff + n * 2048 + k * 1024); } while (0)
#define PG8_MMA(ai, bj, At, Bt) do { __builtin_amdgcn_s_setprio(1); _Pragma("unroll") for (int m = 0; m < 4; ++m) _Pragma("unroll") for (int n = 0; n < 2; ++n) _Pragma("unroll") for (int k = 0; k < 2; ++k) \
        acc[ai][bj][m][n] = __builtin_amdgcn_mfma_f32_16x16x32_bf16(Bt[n][k], At[m][k], acc[ai][bj][m][n], 0, 0, 0); __builtin_amdgcn_s_setprio(0); } while (0)
#define PG8_WAIT_V(n) asm volatile("s_waitcnt vmcnt(" #n ")" ::: "memory")
#define PG8_WAIT_L(n) asm volatile("s_waitcnt lgkmcnt(" #n ")" ::: "memory")
#define PG8_BAR __builtin_amdgcn_s_barrier()
#define PG8_SCHED __builtin_amdgcn_sched_barrier(0)
    Unit cur, nxt; int ui = 0;
    if (!S.next(0, cur)) return;
    f32x4 acc[2][2][4][2];
#pragma unroll
    for (int a = 0; a < 2; ++a)
#pragma unroll
        for (int b = 0; b < 2; ++b)
#pragma unroll
            for (int m = 0; m < 4; ++m)
#pragma unroll
                for (int n = 0; n < 2; ++n) acc[a][b][m][n] = (f32x4){0.f, 0.f, 0.f, 0.f};
    bf16x8 At[4][2], B0[2][2], B1[2][2];
    const char* cA = cur.A; const char* cB = cur.B;
    PG8_STAGE(PG8_SB(0, 0), cB, voffB); PG8_STAGE(PG8_SB(0, 1), cB + hstep, voffB); PG8_STAGE(PG8_SA(0, 0), cA, voffA); PG8_STAGE(PG8_SA(0, 1), cA + hstep, voffA);
    if (wr == 1) PG8_BAR;
    PG8_WAIT_V(2); PG8_BAR;
    PG8_STAGE(PG8_SB(1, 0), cB + kstep, voffB); PG8_STAGE(PG8_SA(1, 0), cA + kstep, voffA); PG8_STAGE(PG8_SB(1, 1), cB + hstep + kstep, voffB);
    PG8_WAIT_V(6); PG8_BAR;
    for (;;) {
        const bool has_next = S.next(ui + 1, nxt);
        const char* nA = has_next ? nxt.A : cA; const char* nB = has_next ? nxt.B : cB;
        const int nt = cur.nt;
        for (int t = 0; t < nt; t += 2) {
            const bool last = (t == nt - 2);
            const char* a1 = cA + (size_t)(t + 1) * kstep;
            const char* a2 = last ? nA : cA + (size_t)(t + 2) * kstep; const char* b2 = last ? nB : cB + (size_t)(t + 2) * kstep;
            const char* a3 = a2 + kstep; const char* b3 = b2 + kstep;
            PG8_LDB(B0, 0, 0); PG8_LDB(B1, 0, 1); PG8_SCHED; PG8_LDA(At, 0, 0); PG8_STAGE(PG8_SA(1, 1), a1 + hstep, voffA);
            PG8_WAIT_V(8); PG8_WAIT_L(0); PG8_BAR; PG8_MMA(0, 0, At, B0); PG8_MMA(0, 1, At, B1); PG8_BAR; PG8_SCHED;
            PG8_LDA(At, 0, 1); PG8_STAGE(PG8_SB(0, 0), b2, voffB); PG8_STAGE(PG8_SB(0, 1), b2 + hstep, voffB); PG8_STAGE(PG8_SA(0, 0), a2, voffA);
            PG8_WAIT_V(8); PG8_WAIT_L(0); PG8_BAR; PG8_MMA(1, 0, At, B0); PG8_MMA(1, 1, At, B1); PG8_BAR; PG8_SCHED;
            PG8_LDB(B0, 1, 0); PG8_LDB(B1, 1, 1); PG8_SCHED; PG8_LDA(At, 1, 0); PG8_STAGE(PG8_SA(0, 1), a2 + hstep, voffA);
            PG8_WAIT_V(8); PG8_WAIT_L(0); PG8_BAR; PG8_MMA(0, 0, At, B0); PG8_MMA(0, 1, At, B1); PG8_BAR; PG8_SCHED;
            PG8_LDA(At, 1, 1); PG8_STAGE(PG8_SB(1, 0), b3, voffB); PG8_STAGE(PG8_SB(1, 1), b3 + hstep, voffB); PG8_STAGE(PG8_SA(1, 0), a3, voffA);
            PG8_WAIT_V(8); PG8_WAIT_L(0); PG8_BAR; PG8_MMA(1, 0, At, B0); PG8_MMA(1, 1, At, B1); PG8_BAR; PG8_SCHED;
        }
        if (wr == 0) PG8_BAR;
        if (!Epi::AFTER_DRAIN || has_next) E(acc, cur, wr, wc, fr, fq);
        if (!has_next) break;
#pragma unroll
        for (int a = 0; a < 2; ++a)
#pragma unroll
            for (int b = 0; b < 2; ++b)
#pragma unroll
                for (int m = 0; m < 4; ++m)
#pragma unroll
                    for (int n = 0; n < 2; ++n) acc[a][b][m][n] = (f32x4){0.f, 0.f, 0.f, 0.f};
        cur = nxt; cA = nA; cB = nB; ++ui;
        if (wr == 1) PG8_BAR;
    }
    PG8_WAIT_V(0);
    PG8_BAR;
    if constexpr (Epi::AFTER_DRAIN) E.fused(acc, cur, wr, wc, fr, fq);
#undef PG8_SA
#undef PG8_SB
#undef PG8_STAGE
#undef PG8_LDA
#undef PG8_LDB
#undef PG8_MMA
#undef PG8_WAIT_V
#undef PG8_WAIT_L
#undef PG8_BAR
#undef PG8_SCHED
}
}

struct Args { const float* in[18]; float* out; unsigned char* ws; int ph_lo, ph_hi; };
struct Ctx { int lane, wave, gw, NGW, G; };

__device__ __forceinline__ float lane_xor(float v, int lane, int mask) { return __int_as_float(__builtin_amdgcn_ds_bpermute((lane ^ mask) << 2, __float_as_int(v))); }
__device__ __forceinline__ float wave_sum(float v, int lane) {
#pragma unroll
    for (int o = 1; o < 64; o <<= 1) v += lane_xor(v, lane, o);
    return v;
}
__device__ __forceinline__ float ss4(const f32x4 v) { return (v.x * v.x + v.y * v.y) + (v.z * v.z + v.w * v.w); }

constexpr size_t WS_CNT = 16384, WS_X1 = 65536, WS_X2 = 65536 + 262144, WS_R = 655360;
constexpr int XL_OFF = 131072 + 1024;
struct PanelEx {
    unsigned* xbuf; unsigned* cnt; unsigned want;
    __device__ __forceinline__ void run(const float (&part)[2][4], const pg8::Unit& u, int wr, int wc, int fr, int fq, LAS unsigned char* xl, int wid, int lane) const {
        LAS float* P = (LAS float*)xl; LAS float* S = (LAS float*)(xl + 4096);
#pragma unroll
        for (int ai = 0; ai < 2; ++ai)
#pragma unroll
            for (int m = 0; m < 4; ++m) { float sq = part[ai][m]; sq += lane_xor(sq, lane, 16); sq += lane_xor(sq, lane, 32);
                if (fq == 0) P[(ai * 128 + wr * 64 + m * 16 + fr) * 4 + wc] = sq; }
        asm volatile("s_waitcnt lgkmcnt(0)" ::: "memory"); __builtin_amdgcn_s_barrier(); asm volatile("" ::: "memory");
        const int row = wid * 32 + (lane & 31);
        if (lane < 32) { const float t = (P[row * 4 + 0] + P[row * 4 + 1]) + (P[row * 4 + 2] + P[row * 4 + 3]);
            __hip_atomic_store(xbuf + (size_t)(u.pm * 256 + row) * 4 + u.pn, __float_as_uint(t), __ATOMIC_RELAXED, __HIP_MEMORY_SCOPE_AGENT); }
        asm volatile("s_waitcnt vmcnt(0)" ::: "memory");
        if (lane == 0) __hip_atomic_fetch_add(cnt + 64 * u.pm, 1u, __ATOMIC_RELAXED, __HIP_MEMORY_SCOPE_AGENT);
        if (wid == 0) {
            unsigned sp = 0;
            while ((unsigned)__builtin_amdgcn_readfirstlane(__hip_atomic_load(cnt + 64 * u.pm, __ATOMIC_RELAXED, __HIP_MEMORY_SCOPE_AGENT)) < want) { __builtin_amdgcn_s_sleep(2); if (++sp > (1u << 22)) break; }
            __builtin_amdgcn_fence(__ATOMIC_ACQUIRE, "agent");
        }
        asm volatile("s_waitcnt vmcnt(0) lgkmcnt(0)" ::: "memory"); __builtin_amdgcn_s_barrier(); asm volatile("" ::: "memory");
        if (lane < 32) { const unsigned* sl = xbuf + (size_t)(u.pm * 256 + row) * 4; float t = 0.f;
#pragma unroll
            for (int q = 0; q < 4; ++q) t += __uint_as_float(__hip_atomic_load(sl + q, __ATOMIC_RELAXED, __HIP_MEMORY_SCOPE_AGENT));
            S[row] = t; }
        asm volatile("s_waitcnt lgkmcnt(0)" ::: "memory"); __builtin_amdgcn_s_barrier(); asm volatile("" ::: "memory");
    }
};
struct EpiNorm {
    static constexpr bool PERM = false, AFTER_DRAIN = true;
    float* P; bf16_t* H; const float* gpost; float alpha; const float* gnext; bf16_t* XN; const float* gkv; bf16_t* XN2; float* yout;
    PanelEx e1, e2; LAS unsigned char* xl; int tid; float* R;
    __device__ __forceinline__ void operator()(f32x4 (&acc)[2][2][4][2], const pg8::Unit& u, int wr, int wc, int fr, int fq) const {
        asm volatile("" : "+v"(fr), "+v"(fq));
        const int col0 = u.pn * 256 + wc * 32 + 4 * fq;
        if (u.pm >= 64) {
            float* base = P + (size_t)u.ks * 256 * D;
#pragma unroll
            for (int ai = 0; ai < 2; ++ai)
#pragma unroll
                for (int m = 0; m < 4; ++m) { float* rowp = base + (size_t)(ai * 128 + wr * 64 + m * 16 + fr) * D + col0;
#pragma unroll
                    for (int bj = 0; bj < 2; ++bj)
#pragma unroll
                        for (int n = 0; n < 2; ++n) *(f32x4*)(rowp + bj * 128 + n * 16) = acc[ai][bj][m][n];
                    asm volatile("" ::: "memory"); }
            return;
        }
    }
    __device__ __forceinline__ void fused(f32x4 (&acc)[2][2][4][2], const pg8::Unit& u, int wr, int wc, int fr, int fq) const {
        asm volatile("" : "+v"(fr), "+v"(fq));
        const int col0 = u.pn * 256 + wc * 32 + 4 * fq;
        int lane = tid & 63; asm volatile("" : "+v"(lane));
        const int wid = wr * 4 + wc;
        const LAS float* S = (const LAS float*)(xl + 4096);
        float part[2][4];
#pragma unroll
        for (int ai = 0; ai < 2; ++ai)
#pragma unroll
            for (int m = 0; m < 4; ++m) { float sq = 0.f;
#pragma unroll
                for (int bj = 0; bj < 2; ++bj)
#pragma unroll
                    for (int n = 0; n < 2; ++n) sq += ss4(acc[ai][bj][m][n]);
                part[ai][m] = sq; }
        u32x2 hraw[4][2][2];
#pragma unroll
        for (int m = 0; m < 4; ++m) { const bf16_t* hp = H + (size_t)(u.pm * 256 + wr * 64 + m * 16 + fr) * D + col0;
#pragma unroll
            for (int bj = 0; bj < 2; ++bj)
#pragma unroll
                for (int n = 0; n < 2; ++n) hraw[m][bj][n] = *(const u32x2*)(hp + bj * 128 + n * 16); }
        e1.run(part, u, wr, wc, fr, fq, xl, wid, lane);
        {
            f32x4 g[2][2];
#pragma unroll
            for (int bj = 0; bj < 2; ++bj)
#pragma unroll
                for (int n = 0; n < 2; ++n) g[bj][n] = *(const f32x4*)(gpost + col0 + bj * 128 + n * 16);
#pragma unroll
            for (int ai = 0; ai < 2; ++ai)
#pragma unroll
                for (int m = 0; m < 4; ++m) { const int r = ai * 128 + wr * 64 + m * 16 + fr; const float rf = alpha * __builtin_amdgcn_rsqf(S[r] * (1.0f / D) + EPS);
                    float sq = 0.f;
#pragma unroll
                    for (int bj = 0; bj < 2; ++bj)
#pragma unroll
                        for (int n = 0; n < 2; ++n) { const u32x2 hw = (ai == 0) ? hraw[m][bj][n] : *(const u32x2*)(H + (size_t)(u.pm * 256 + r) * D + col0 + bj * 128 + n * 16); const f32x4 ho = (f32x4){bf_lo(hw.x), bf_hi(hw.x), bf_lo(hw.y), bf_hi(hw.y)}; const f32x4 hn = ho + acc[ai][bj][m][n] * rf * g[bj][n]; acc[ai][bj][m][n] = hn; sq += ss4(hn); }
                    part[ai][m] = sq;
                    asm volatile("" : "+v"(acc[ai][0][m][0]), "+v"(acc[ai][0][m][1]), "+v"(acc[ai][1][m][0]), "+v"(acc[ai][1][m][1]), "+v"(part[ai][m]));
                    if (m & 1) asm volatile("" ::: "memory"); }
        }
        e2.run(part, u, wr, wc, fr, fq, xl, wid, lane);
        {
#pragma unroll
            for (int ai = 0; ai < 2; ++ai)
#pragma unroll
                for (int m = 0; m < 4; ++m) { const int r = ai * 128 + wr * 64 + m * 16 + fr;
                    const size_t off = (size_t)(u.pm * 256 + r) * D + col0;
                    if (u.pn == 0 && wc == 0 && fq == 0) R[u.pm * 256 + r] = __builtin_amdgcn_rsqf(S[r] * (1.0f / D) + EPS);
#pragma unroll
                    for (int bj = 0; bj < 2; ++bj)
#pragma unroll
                        for (int n = 0; n < 2; ++n) { const f32x4 hn = acc[ai][bj][m][n];
                            if (yout) *(f32x4*)(yout + O_YP + off + bj * 128 + n * 16) = hn; else st_bf4(H + off + bj * 128 + n * 16, hn); }
                    asm volatile("" ::: "memory"); }
        }
    }
};

struct TrJob { const float* W; bf16_t* WT; const float* gain; int K, N, mode, item; };
struct TrSrc { const float *w_gate, *w_up, *w_down, *p_win, *w_k, *w_v, *a_wo, *a_wq, *norm_g, *kv_norm; unsigned char* ws; };
constexpr int TR_I_FFN = 24 * 1408, TR_I_SQ = 6 * 512, TR_I_Q = 2 * 1536, TR_NITEMS = TR_I_FFN + TR_I_SQ + TR_I_Q;
__device__ __forceinline__ void tr_decode(const TrSrc& T, int it, TrJob& j) {
    int r = it;
    if (r < TR_I_FFN) { const int job = r / 1408, li = job / 3, kind = job % 3; j.item = r % 1408;
        bf16_t* dst = (bf16_t*)(T.ws + WS_FFN + (size_t)li * FFN_STRIDE);
        const float* gpre = T.norm_g + (size_t)((li >> 1) * 6 + ((li & 1) ? 4 : 0)) * D;
        if (kind == 0) { j.W = T.w_gate + (size_t)li * D * FF; j.K = D; j.N = FF; j.WT = dst; j.mode = 1; j.gain = gpre; }
        else if (kind == 1) { j.W = T.w_up + (size_t)li * D * FF; j.K = D; j.N = FF; j.WT = dst; j.mode = 2; j.gain = gpre; }
        else { j.W = T.w_down + (size_t)li * D * FF; j.K = FF; j.N = D; j.WT = (bf16_t*)((unsigned char*)dst + WD_OFF); j.mode = 0; j.gain = nullptr; }
        return; }
    r -= TR_I_FFN;
    if (r < TR_I_SQ) { const int job = r / 512; j.item = r % 512; j.K = D; j.N = D; j.mode = 0;
        if (job < 2) { j.W = T.p_win + (size_t)job * D * D; j.WT = (bf16_t*)(T.ws + WS_WIN) + (size_t)job * D * D; j.gain = T.norm_g + (size_t)(job * 6 + 2) * D; }
        else if (job == 2) { j.W = T.w_k; j.WT = (bf16_t*)(T.ws + WS_WKV); j.gain = T.kv_norm; }
        else if (job == 3) { j.W = T.w_v; j.WT = (bf16_t*)(T.ws + WS_WKV) + (size_t)D * D; j.gain = T.kv_norm; }
        else { j.W = T.a_wo + (size_t)(job - 4) * D * D; j.WT = (bf16_t*)(T.ws + WS_WO) + (size_t)(job - 4) * D * D; j.gain = nullptr; }
        return; }
    r -= TR_I_SQ;
    { const int job = r / 1536; j.item = r % 1536; j.K = D; j.N = NQ; j.mode = 0; j.W = T.a_wq + (size_t)job * D * NQ; j.WT = (bf16_t*)(T.ws + WS_WQ) + (size_t)job * NQ * D; j.gain = T.norm_g + (size_t)((2 + job) * 6 + 2) * D; }
}
__device__ __forceinline__ void tr_load(const TrJob& j, int lane, float (&v)[32]) {
    const int nblk = j.N / 32, kb = j.item / nblk, nb = j.item % nblk, k0 = 64 * kb, n0 = 32 * nb;
    const float* p = j.W + (size_t)(k0 + (lane >> 5)) * j.N + n0 + (lane & 31);
#pragma unroll
    for (int i = 0; i < 32; ++i) v[i] = __builtin_nontemporal_load(p + (size_t)(2 * i) * j.N);
}
__device__ __forceinline__ void tr_finish(const TrJob& j, int lane, LAS float* scr, const float (&v)[32]) {
    const int nblk = j.N / 32, kb = j.item / nblk, nb = j.item % nblk, k0 = 64 * kb, n0 = 32 * nb;
#pragma unroll
    for (int i = 0; i < 32; ++i) scr[(2 * i + (lane >> 5)) * 33 + (lane & 31)] = v[i];
    asm volatile("s_waitcnt lgkmcnt(0)" ::: "memory");
    const int orow0 = (j.mode == 0) ? n0 : ((n0 >> 7) * 256 + (n0 & 127) + (j.mode == 2 ? 128 : 0));
    const int c = lane & 7;
    f32x4 ga = {1.f, 1.f, 1.f, 1.f}, gb = {1.f, 1.f, 1.f, 1.f};
    if (j.gain) { ga = *(const f32x4*)(j.gain + k0 + 8 * c); gb = *(const f32x4*)(j.gain + k0 + 8 * c + 4); }
#pragma unroll
    for (int q = 0; q < 4; ++q) { const int n = (lane >> 3) + 8 * q; const LAS float* sp = scr + (8 * c) * 33 + n;
        u32x4 o; o.x = pk2(sp[0 * 33] * ga.x, sp[1 * 33] * ga.y); o.y = pk2(sp[2 * 33] * ga.z, sp[3 * 33] * ga.w); o.z = pk2(sp[4 * 33] * gb.x, sp[5 * 33] * gb.y); o.w = pk2(sp[6 * 33] * gb.z, sp[7 * 33] * gb.w);
        *(u32x4*)(j.WT + (size_t)(orow0 + n) * j.K + k0 + 8 * c) = o; }
    asm volatile("s_waitcnt lgkmcnt(0)" ::: "memory");
}

template <int NR>
__device__ __forceinline__ void norm_rows(int lane, int m0, int stride, int mode, const float* xp, const float* xs, const float* Fb, const float* Pb, int nsplit, const float* gpost, float alpha,
                                          bf16_t* H, const float* gnext, bf16_t* XN, const float* gkv, bf16_t* XN2, float* yout, float* R) {
    f32x4 h[NR][4]; size_t ro[NR];
#pragma unroll
    for (int k = 0; k < NR; ++k) ro[k] = (size_t)(m0 + k * stride) * D + 4 * lane;
    if (mode == 0) {
#pragma unroll
        for (int k = 0; k < NR; ++k) { const int m = m0 + k * stride; const float* src = (m < MP) ? xp + ro[k] : xs + (ro[k] - (size_t)MP * D);
#pragma unroll
            for (int j = 0; j < 4; ++j) h[k][j] = *(const f32x4*)(src + 256 * j); }
    } else {
        f32x4 f[NR][4];
#pragma unroll
        for (int k = 0; k < NR; ++k) { const int m = m0 + k * stride;
            if (m < MP) {
#pragma unroll
                for (int j = 0; j < 4; ++j) f[k][j] = *(const f32x4*)(Fb + ro[k] + 256 * j);
            } else {
                const float* p = Pb + (size_t)(m - MP) * D + 4 * lane;
#pragma unroll
                for (int j = 0; j < 4; ++j) f[k][j] = *(const f32x4*)(p + 256 * j);
                int s = 1;
                for (; s + 3 < nsplit; s += 4) {
                    f32x4 t[4][4];
#pragma unroll
                    for (int q = 0; q < 4; ++q)
#pragma unroll
                        for (int j = 0; j < 4; ++j) t[q][j] = *(const f32x4*)(p + (size_t)(s + q) * MS * D + 256 * j);
#pragma unroll
                    for (int j = 0; j < 4; ++j) f[k][j] += (t[0][j] + t[1][j]) + (t[2][j] + t[3][j]);
                }
                for (; s < nsplit; ++s) {
#pragma unroll
                    for (int j = 0; j < 4; ++j) f[k][j] += *(const f32x4*)(p + (size_t)s * MS * D + 256 * j);
                }
            }
#pragma unroll
            for (int j = 0; j < 4; ++j) h[k][j] = ld_bf4(H + ro[k] + 256 * j);
        }
        f32x4 g[4];
#pragma unroll
        for (int j = 0; j < 4; ++j) g[j] = *(const f32x4*)(gpost + 4 * lane + 256 * j);
#pragma unroll
        for (int k = 0; k < NR; ++k) {
            float ss = 0.f;
#pragma unroll
            for (int j = 0; j < 4; ++j) ss += ss4(f[k][j]);
            const float rf = alpha * __builtin_amdgcn_rsqf(wave_sum(ss, lane) * (1.0f / D) + EPS);
#pragma unroll
            for (int j = 0; j < 4; ++j) h[k][j] += f[k][j] * rf * g[j];
        }
    }
    float rh[NR];
#pragma unroll
    for (int k = 0; k < NR; ++k) {
        float ss = 0.f;
#pragma unroll
        for (int j = 0; j < 4; ++j) ss += ss4(h[k][j]);
        rh[k] = __builtin_amdgcn_rsqf(wave_sum(ss, lane) * (1.0f / D) + EPS);
    }
    if (yout) {
#pragma unroll
        for (int k = 0; k < NR; ++k) { const int m = m0 + k * stride; float* yo = (m < MP) ? yout + O_YP + ro[k] : yout + O_YS + (ro[k] - (size_t)MP * D);
#pragma unroll
            for (int j = 0; j < 4; ++j) *(f32x4*)(yo + 256 * j) = h[k][j]; }
    } else {
#pragma unroll
        for (int k = 0; k < NR; ++k) {
#pragma unroll
            for (int j = 0; j < 4; ++j) st_bf4(H + ro[k] + 256 * j, h[k][j]);
            if (lane == 0) R[m0 + k * stride] = rh[k];
        }
    }
}
__device__ __forceinline__ void norm_pass(const Ctx& C0, int mode, const float* xp, const float* xs, const float* Fb, const float* Pb, int nsplit, const float* gpost, float alpha,
                                          bf16_t* H, const float* gnext, bf16_t* XN, const float* gkv, bf16_t* XN2, float* yout, float* R, int m_lo = 0) {
    Ctx C = C0; asm volatile("" : "+v"(C.lane));
    int m = m_lo + C.gw;
    for (; m + 3 * C.NGW < M; m += 4 * C.NGW) norm_rows<4>(C.lane, m, C.NGW, mode, xp, xs, Fb, Pb, nsplit, gpost, alpha, H, gnext, XN, gkv, XN2, yout, R);
    for (; m < M; m += C.NGW) norm_rows<1>(C.lane, m, C.NGW, mode, xp, xs, Fb, Pb, nsplit, gpost, alpha, H, gnext, XN, gkv, XN2, yout, R);
}

template <int NS>
__device__ __forceinline__ void norm_sample_wg(int tid_, int wave, int row, LAS float* red, const float* Pb, const float* gpost, float alpha, bf16_t* H, const float* gnext, bf16_t* XN,
                                               const float* gkv, bf16_t* XN2, float* yout, float* R) {
    int tid = tid_; asm volatile("" : "+v"(tid));
    const int lane = tid & 63, c = 2 * tid;
    const float* p = Pb + (size_t)row * D + c;
    f32x2 pv[NS];
#pragma unroll
    for (int q = 0; q < NS; ++q) pv[q] = *(const f32x2*)(p + (size_t)q * MS * D);
    const size_t ro = (size_t)(MP + row) * D + c;
    const unsigned hw = *(const unsigned*)(H + ro);
    const f32x2 g1 = *(const f32x2*)(gpost + c);
    f32x2 f = pv[0];
#pragma unroll
    for (int q = 1; q < NS; ++q) f += pv[q];
    float ss = wave_sum(f.x * f.x + f.y * f.y, lane);
    if (lane == 0) red[wave] = ss;
    __syncthreads();
    float tot = 0.f;
#pragma unroll
    for (int q = 0; q < 8; ++q) tot += red[q];
    const float rf = alpha * __builtin_amdgcn_rsqf(tot * (1.0f / D) + EPS);
    const f32x2 h = (f32x2){bf_lo(hw), bf_hi(hw)} + f * rf * g1;
    ss = wave_sum(h.x * h.x + h.y * h.y, lane);
    if (lane == 0) red[8 + wave] = ss;
    __syncthreads();
    tot = 0.f;
#pragma unroll
    for (int q = 0; q < 8; ++q) tot += red[8 + q];
    const float rh = __builtin_amdgcn_rsqf(tot * (1.0f / D) + EPS);
    if (yout) { *(f32x2*)(yout + O_YS + (size_t)row * D + c) = h; }
    else { *(unsigned*)(H + ro) = pk2(h.x, h.y); if (tid == 0) R[MP + row] = rh; }
}

__device__ __forceinline__ void pool_pass(const Ctx& C0, int layer, const bf16_t* Ub, const float* Pb, int nsplit, const float* state, bf16_t* Z, float* out) {
    Ctx C = C0; asm volatile("" : "+v"(C.lane));
    const int NIT = NB * 64 * 4 + DB * 4;
    for (int it = C.gw; it < NIT; it += C.NGW) {
        if (it < NB * 64 * 4) {
            const int cgp = it & 3, chunk = (it >> 2) & 63, b = it >> 8, w = 2 << cgp, col = cgp * 256 + 4 * C.lane, t0 = chunk * 32;
            const bf16_t* U = Ub + (size_t)b * SEQ * D + col; bf16_t* Zb = Z + (size_t)b * SEQ * D + col;
            f32x4 s = {0.f, 0.f, 0.f, 0.f};
            {
                f32x4 pre[15];
#pragma unroll
                for (int j = 1; j < 16; ++j) { const int t = t0 - j; pre[j - 1] = ld_bf4(U + (size_t)((j < w && t >= 0) ? t : t0) * D); }
#pragma unroll
                for (int j = 1; j < 16; ++j) { const int t = t0 - j; s += pre[j - 1] * ((j < w && t >= 0) ? 1.0f : 0.0f); }
            }
            for (int tb = t0; tb < t0 + 32; tb += 8) {
                f32x4 ua[8], ub[8];
#pragma unroll
                for (int q = 0; q < 8; ++q) { const int t = tb + q, tp = t - w + 1; ua[q] = ld_bf4(U + (size_t)t * D); ub[q] = ld_bf4(U + (size_t)(tp >= 0 ? tp : 0) * D); }
#pragma unroll
                for (int q = 0; q < 8; ++q) { const int t = tb + q, tp = t - w + 1; const f32x4 ut = ua[q];
                    s += ut;
                    const float rc = 1.0f / (float)((t + 1 < w) ? (t + 1) : w);
                    const f32x4 z = s * rc - ut;
                    u32x2 o; o.x = pk2(z.x, z.y); o.y = pk2(z.z, z.w); *(u32x2*)(Zb + (size_t)t * D) = o;
                    if (tp >= 0) s -= ub[q]; }
            }
        } else {
            const int r = it - NB * 64 * 4, cgp = r & 3, b = r >> 2, w = 2 << cgp, col = cgp * 256 + 4 * C.lane;
            f32x4 ext[23];
            const float* st = state + ((size_t)(layer * DB + b) * 15) * D + col;
#pragma unroll
            for (int e = 0; e < 15; ++e) ext[e] = *(const f32x4*)(st + (size_t)e * D);
#pragma unroll
            for (int t = 0; t < 8; ++t) {
                const float* p = Pb + (size_t)(b * 8 + t) * D + col; f32x4 pa[8];
#pragma unroll
                for (int s = 0; s < 8; ++s) pa[s] = *(const f32x4*)(p + (size_t)s * MS * D);
                ext[15 + t] = ((pa[0] + pa[1]) + (pa[2] + pa[3])) + ((pa[4] + pa[5]) + (pa[6] + pa[7]));
            }
            bf16_t* Zb = Z + ((size_t)MP + b * 8) * D + col; float* po = out + O_PS + ((size_t)(layer * DB + b) * 15) * D + col;
            const float rc = 1.0f / (float)w;
#pragma unroll
            for (int t = 0; t < 8; ++t) {
                f32x4 s = {0.f, 0.f, 0.f, 0.f};
#pragma unroll
                for (int j = 0; j < 16; ++j) if (j < w) s += ext[15 + t - j];
                const f32x4 z = s * rc - ext[15 + t];
                u32x2 o; o.x = pk2(z.x, z.y); o.y = pk2(z.z, z.w); *(u32x2*)(Zb + (size_t)t * D) = o;
            }
#pragma unroll
            for (int i = 0; i < 15; ++i) *(f32x4*)(po + (size_t)i * D) = ext[8 + i];
        }
    }
}

#define MFMA32(a, b, c) __builtin_amdgcn_mfma_f32_32x32x16_bf16((a), (b), (c), 0, 0, 0)
constexpr int VROW = 192;
constexpr int NT_P = NB * NH * 3 * 64, NT_S = DB * NH * 13, NT_ALL = NT_P + NT_S;
constexpr int KROW = 144;
constexpr int ATT_WL = 32 * KROW + 32 * VROW;
template <int KB0>
__device__ __forceinline__ void attn_task(LAS unsigned char* wl, int lane, const bf16_t* qp, const bf16_t* Kb, const bf16_t* Vb, int pk0, int pkstep, int pkmax, int coloff, float slope_d,
                                          bool qvalid, bf16_t* op, float* lsep) {
    const int rr = lane & 31, hh = lane >> 5;
    const int trq = (lane & 15) >> 2, trp = lane & 3, trblk = (lane >> 4) & 1;
    const int lr = lane >> 3, lc = lane & 7;
    LAS unsigned char* kt = wl; LAS unsigned char* vt_ = wl + 32 * KROW;
    bf16x8 qf[4];
#pragma unroll
    for (int s = 0; s < 4; ++s) qf[s] = *(const bf16x8*)(qp + 16 * s);
    unsigned off[5][4];
#pragma unroll
    for (int kb = KB0; kb < 5; ++kb)
#pragma unroll
        for (int j = 0; j < 4; ++j) { int pk = pk0 + (32 * kb + 8 * j) * pkstep; pk = pk > pkmax ? pkmax : pk; off[kb][j] = (unsigned)(pk * D + coloff); }
    bf16x8 kr[5][4];
#pragma unroll
    for (int kb = KB0; kb < 5; ++kb)
#pragma unroll
        for (int j = 0; j < 4; ++j) kr[kb][j] = *(const bf16x8*)(Kb + off[kb][j]);
    bf16x8 vr[5][4];
#pragma unroll
    for (int kb = KB0; kb < 5; ++kb)
#pragma unroll
        for (int j = 0; j < 4; ++j) vr[kb][j] = *(const bf16x8*)(Vb + off[kb][j]);
    float p[5][16];
    float mx = -3.0e38f;
    const int base = rr + 128 - 4 * hh;
#pragma unroll
    for (int kb = KB0; kb < 5; ++kb) {
#pragma unroll
        for (int j = 0; j < 4; ++j) *(LAS bf16x8*)(kt + (8 * j + lr) * KROW + 16 * lc) = kr[kb][j];
        bf16x8 kf[4];
#pragma unroll
        for (int s = 0; s < 4; ++s) kf[s] = *(const LAS bf16x8*)(kt + rr * KROW + 32 * s + 16 * hh);
        const float tk = -slope_d * (float)(base - 32 * kb);
        f32x16 a;
#pragma unroll
        for (int i = 0; i < 16; ++i) a[i] = __builtin_fmaf(slope_d, (float)((i & 3) + 8 * (i >> 2)), tk);
#pragma unroll
        for (int s = 0; s < 4; ++s) a = MFMA32(kf[s], qf[s], a);
#pragma unroll
        for (int i = 0; i < 16; ++i) {
            float v = a[i];
            if (kb == 0) v = ((i & 3) + 8 * (i >> 2) + 4 * hh >= rr) ? v : -1.0e30f;
            if (kb == 4) v = ((i & 3) + 8 * (i >> 2) + 4 * hh <= rr) ? v : -1.0e30f;
            p[kb][i] = v; mx = fmaxf(mx, v);
        }
    }
    mx = fmaxf(mx, lane_xor(mx, lane, 32));
    float l = 0.f;
    f32x16 o[2];
#pragma unroll
    for (int i = 0; i < 16; ++i) { o[0][i] = 0.f; o[1][i] = 0.f; }
#pragma unroll
    for (int kb = KB0; kb < 5; ++kb) {
#pragma unroll
        for (int i = 0; i < 16; ++i) { const float e = __builtin_amdgcn_exp2f(p[kb][i] - mx); p[kb][i] = e; l += e; }
#pragma unroll
        for (int j = 0; j < 4; ++j) *(LAS bf16x8*)(vt_ + (8 * j + lr) * VROW + 16 * lc) = vr[kb][j];
#pragma unroll
        for (int s2 = 0; s2 < 2; ++s2) {
            u32x4 pw;
            pw.x = pk2(p[kb][8 * s2 + 0], p[kb][8 * s2 + 1]); pw.y = pk2(p[kb][8 * s2 + 2], p[kb][8 * s2 + 3]);
            pw.z = pk2(p[kb][8 * s2 + 4], p[kb][8 * s2 + 5]); pw.w = pk2(p[kb][8 * s2 + 6], p[kb][8 * s2 + 7]);
            const bf16x8 pf = __builtin_bit_cast(bf16x8, pw);
#pragma unroll
            for (int nb = 0; nb < 2; ++nb) {
                const s16x4 lo = __builtin_amdgcn_ds_read_tr16_b64_v4i16((LAS s16x4*)(vt_ + (16 * s2 + 4 * hh + trq) * VROW + 64 * nb + 32 * trblk + 8 * trp));
                const s16x4 hi = __builtin_amdgcn_ds_read_tr16_b64_v4i16((LAS s16x4*)(vt_ + (16 * s2 + 8 + 4 * hh + trq) * VROW + 64 * nb + 32 * trblk + 8 * trp));
                const bf16x8 vt = __builtin_shufflevector(lo, hi, 0, 1, 2, 3, 4, 5, 6, 7);
                o[nb] = MFMA32(vt, pf, o[nb]);
            }
        }
    }
    l += lane_xor(l, lane, 32);
    const float inv = 1.0f / l;
    if (qvalid) {
#pragma unroll
        for (int nb = 0; nb < 2; ++nb)
#pragma unroll
            for (int q4 = 0; q4 < 4; ++q4) { u32x2 w; w.x = pk2(o[nb][4 * q4] * inv, o[nb][4 * q4 + 1] * inv); w.y = pk2(o[nb][4 * q4 + 2] * inv, o[nb][4 * q4 + 3] * inv);
                *(u32x2*)(op + 32 * nb + 8 * q4) = w; }
        if (hh == 0) *lsep = (mx + __builtin_amdgcn_logf(l)) * 0.6931471805599453f;
    }
}
__device__ __forceinline__ void attn_phase(const Ctx& C, int amode, int bx, LAS unsigned char* lds, const bf16_t* Q, const bf16_t* KB, const bf16_t* VB, const bf16_t* KBS, const bf16_t* VBS, bf16_t* OG, float* LSE) {
    LAS unsigned char* wl = lds + C.wave * ATT_WL;
    int lane0 = C.lane;
    const bool xa = (C.G == 256);
    const int xcd = bx & 7, jw = bx >> 3;
    const int nit = xa ? 12 + 4 : (NT_ALL / 8 + C.G - 1) / C.G;
    for (int it = 0; it < nit; ++it) {
        int ch = 0, Tp = -1;
        if (xa) {
            if (it < 12) { const int q = jw + 32 * it, gb = q >> 1, hd = (q & 1) * 8 + C.wave; Tp = ((xcd * 16 + hd) * 3 + gb / 64) * 64 + (gb % 64); }
            else { const int q = jw + 32 * (it - 12); if (q >= 104) break; ch = NT_P / 8 + 104 * xcd + q; }
        } else { ch = bx + it * C.G; if (ch >= NT_ALL / 8) break; }
        const int T = (Tp >= 0) ? Tp : ch * 8 + C.wave;
        if (!((T < NT_P) ? (amode & 1) : (amode & 2))) continue;
        int lane = lane0; asm volatile("" : "+v"(lane));
        const int rr = lane & 31, hh = lane >> 5;
        int b, h, g, r, i0, seqlen, qlo, qhi, mbase; const bf16_t *Kb, *Vb;
        if (T < NT_P) {
            const int blk = T & 63; int x = T >> 6; g = x % 3; x /= 3; h = x & 15; b = x >> 4;
            const int sh_ = 2 * g, nbs = 64 >> sh_; r = blk / nbs; i0 = (blk % nbs) * 32;
            seqlen = SEQ; qlo = 0; qhi = SEQ; mbase = b * SEQ; Kb = KB + (size_t)b * SEQ * D; Vb = VB + (size_t)b * SEQ * D;
        } else {
            int x = T - NT_P; h = x & 15; x >>= 4; const int k = x % 13; b = x / 13;
            if (k == 0) { g = 0; r = 0; i0 = 2048; } else if (k < 5) { g = 1; r = k - 1; i0 = 512; } else { g = 2; r = k - 5; i0 = 128; }
            seqlen = SROWS; qlo = KVB; qhi = SROWS; mbase = MP + b * DT; Kb = KBS + (size_t)b * SROWS * D; Vb = VBS + (size_t)b * SROWS * D;
        }
        const int sh = 2 * g;
        const float slope_d = __builtin_amdgcn_exp2f(-0.5f * (float)(h + 1)) * (float)(1 << sh) * 1.4426950408889634f;
        const int pq = r + ((i0 + rr) << sh);
        const bool qvalid = (pq >= qlo) && (pq < qhi);
        const int pqc = pq < qlo ? qlo : (pq >= qhi ? qhi - 1 : pq);
        const int mrow = mbase + pqc - qlo;
        const bf16_t* qp = Q + (size_t)mrow * NQ + g * D + h * HD + 8 * hh;
        const int pk0 = r + ((i0 - 128 + (lane >> 3)) << sh), pkstep = 1 << sh, coloff = h * HD + 8 * (lane & 7);
        bf16_t* op = OG + ((size_t)g * M + mrow) * D + h * HD + 4 * hh; float* lsep = LSE + ((size_t)g * M + mrow) * NH + h;
        const int kb0 = (i0 < 128) ? ((128 - i0) >> 5) : 0;
        if (kb0 == 0) attn_task<0>(wl, lane, qp, Kb, Vb, pk0, pkstep, seqlen - 1, coloff, slope_d, qvalid, op, lsep);
        else if (kb0 == 1) attn_task<1>(wl, lane, qp, Kb, Vb, pk0, pkstep, seqlen - 1, coloff, slope_d, qvalid, op, lsep);
        else if (kb0 == 2) attn_task<2>(wl, lane, qp, Kb, Vb, pk0, pkstep, seqlen - 1, coloff, slope_d, qvalid, op, lsep);
        else if (kb0 == 3) attn_task<3>(wl, lane, qp, Kb, Vb, pk0, pkstep, seqlen - 1, coloff, slope_d, qvalid, op, lsep);
        else attn_task<4>(wl, lane, qp, Kb, Vb, pk0, pkstep, seqlen - 1, coloff, slope_d, qvalid, op, lsep);
    }
}

__device__ __forceinline__ void combine_pass(const Ctx& C0, const bf16_t* OG, const float* LSE, bf16_t* O) {
    Ctx C = C0; asm volatile("" : "+v"(C.lane));
    const int head = C.lane >> 2;
    constexpr int NR = 4;
    for (int m0 = C.gw; m0 < M; m0 += NR * C.NGW) {
        float l[NR][3]; u32x4 og[NR][3][2]; int mm[NR];
#pragma unroll
        for (int k = 0; k < NR; ++k) { const int m = m0 + k * C.NGW; mm[k] = m < M ? m : m0;
#pragma unroll
            for (int g = 0; g < 3; ++g) { l[k][g] = LSE[((size_t)g * M + mm[k]) * NH + head];
#pragma unroll
                for (int hf = 0; hf < 2; ++hf) og[k][g][hf] = *(const u32x4*)(OG + ((size_t)g * M + mm[k]) * D + 16 * C.lane + 8 * hf); } }
#pragma unroll
        for (int k = 0; k < NR; ++k) {
            if (m0 + k * C.NGW >= M) break;
            const float mx = fmaxf(l[k][0], fmaxf(l[k][1], l[k][2]));
            float w0 = __expf(l[k][0] - mx), w1 = __expf(l[k][1] - mx), w2 = __expf(l[k][2] - mx);
            const float inv = 1.0f / (w0 + w1 + w2); w0 *= inv; w1 *= inv; w2 *= inv;
#pragma unroll
            for (int hf = 0; hf < 2; ++hf) {
                const u32x4 a = og[k][0][hf], b = og[k][1][hf], c = og[k][2][hf];
                u32x4 w;
#pragma unroll
                for (int e = 0; e < 4; ++e) w[e] = pk2(w0 * bf_lo(a[e]) + w1 * bf_lo(b[e]) + w2 * bf_lo(c[e]), w0 * bf_hi(a[e]) + w1 * bf_hi(b[e]) + w2 * bf_hi(c[e]));
                *(u32x4*)(O + (size_t)mm[k] * D + 16 * C.lane + 8 * hf) = w;
            }
        }
    }
}

constexpr int CP_ROWS = KVB - DT, CP_ITEMS = 2 * DB * CP_ROWS;
constexpr int CP_Q_UG = 10176, CP_Q_WQ = 23424, CP_Q_KV = CP_ITEMS - 8 * CP_Q_UG - 2 * CP_Q_WQ;
static_assert(CP_Q_KV >= 0 && CP_Q_KV < 4000, "copy quotas");
__device__ __forceinline__ void copy_rows(int lane_, int nw, int nwaves, int lo, int cnt, const float* cache_k, const float* cache_v, float* out) {
    int lane = lane_; asm volatile("" : "+v"(lane));
    constexpr int NB_ = 4;
    for (int i = nw; i < cnt; i += NB_ * nwaves) {
        const float* src[NB_]; float* dst[NB_]; bool ok[NB_];
#pragma unroll
        for (int k = 0; k < NB_; ++k) { const int ii = i + k * nwaves; ok[k] = ii < cnt; const int idx = lo + (ok[k] ? ii : i);
            const int kv = idx / (DB * CP_ROWS), rem = idx % (DB * CP_ROWS), b = rem / CP_ROWS, jo = rem % CP_ROWS;
            src[k] = (kv ? cache_v : cache_k) + ((size_t)b * KVB + jo + DT) * D + 4 * lane; dst[k] = out + (kv ? O_VS : O_KS) + ((size_t)b * KVB + jo) * D + 4 * lane; }
        f32x4 v[NB_][4];
#pragma unroll
        for (int k = 0; k < NB_; ++k)
#pragma unroll
            for (int q = 0; q < 4; ++q) v[k][q] = __builtin_nontemporal_load((const f32x4*)(src[k] + 256 * q));
#pragma unroll
        for (int k = 0; k < NB_; ++k)
            if (ok[k]) {
#pragma unroll
                for (int q = 0; q < 4; ++q) __builtin_nontemporal_store(v[k][q], (f32x4*)(dst[k] + 256 * q));
            }
    }
}

#define XB_TMO      128
#define XB_XCNT(j)  (256  + 64 * (j))
#define XB_XSUB(j)  (1280 + 64 * (j))
#define XB_XGEN(j)  (2304 + 64 * (j))
#define XB_TOP      3328
#define XB_TOPGEN   3392
#define XCD_BAR_WORDS 3456
#define XB_SPIN_CAP (1u << 20)
__device__ __forceinline__ unsigned xb_ld(unsigned* p)              { return __hip_atomic_load(p, __ATOMIC_RELAXED, __HIP_MEMORY_SCOPE_AGENT); }
__device__ __forceinline__ unsigned xb_add(unsigned* p, unsigned v) { return __hip_atomic_fetch_add(p, v, __ATOMIC_RELAXED, __HIP_MEMORY_SCOPE_AGENT); }
__device__ __forceinline__ unsigned xb_xcc_id() { return (unsigned)__builtin_amdgcn_s_getreg((3 << 11) | 20) & 0xFu; }
#define XB_SPIN(cond, bar) do { unsigned _sp = 0; while (cond) { __builtin_amdgcn_s_sleep(1); \
    if ((++_sp & 255u) == 0u) { if (xb_ld(&(bar)[XB_TMO])) break; if (_sp > XB_SPIN_CAP) { atomicAdd(&(bar)[XB_TMO], 1u); break; } } } } while (0)
struct XcdBarrier { unsigned* bar; unsigned x; volatile LAS unsigned* st; };
__device__ __forceinline__ XcdBarrier xcd_barrier_post(unsigned* bar, volatile LAS unsigned* st) {
    XcdBarrier b; b.bar = bar; b.x = xb_xcc_id(); b.st = st;
    if (threadIdx.x == 0) (void)xb_add(&bar[XB_XCNT(b.x)], 1u);
    return b;
}
__device__ __forceinline__ void xcd_barrier_complete(unsigned* bar, unsigned x, unsigned& nloc, unsigned& nx) {
    const unsigned G = gridDim.x * gridDim.y * gridDim.z;
    unsigned sum, cnt, mine, sp = 0u;
    for (;;) {
        sum = 0u; cnt = 0u; mine = 0u;
#pragma unroll
        for (unsigned j = 0; j < 16; ++j) { const unsigned c = xb_ld(&bar[XB_XCNT(j)]); sum += c; cnt += (c > 0u) ? 1u : 0u; mine = (j == x) ? c : mine; }
        if (sum == G) break;
        __builtin_amdgcn_s_sleep(1);
        if ((++sp & 255u) == 0u) { if (xb_ld(&bar[XB_TMO])) break; if (sp > XB_SPIN_CAP) { atomicAdd(&bar[XB_TMO], 1u); break; } }
    }
    nloc = mine > 0u ? mine : 1u; nx = cnt > 0u ? cnt : 1u;
}
__device__ __forceinline__ void xcd_barrier(const XcdBarrier& b) {
    asm volatile("s_waitcnt vmcnt(0)" ::: "memory");
    __syncthreads();
    if (threadIdx.x == 0) {
        unsigned* bar = b.bar;
        __builtin_amdgcn_s_waitcnt(0);
        unsigned nloc = b.st[0], nx = b.st[1];
        if (nloc == 0u) { xcd_barrier_complete(bar, b.x, nloc, nx); b.st[0] = nloc; b.st[1] = nx; }
        const unsigned old = xb_add(&bar[XB_XSUB(b.x)], 1u);
        const unsigned gen = old / nloc;
        if (old + 1u == (gen + 1u) * nloc) {
            __builtin_amdgcn_fence(__ATOMIC_RELEASE, "agent");
            asm volatile("s_waitcnt vmcnt(0)" ::: "memory");
            const unsigned og = xb_add(&bar[XB_TOP], 1u);
            const unsigned tg = og / nx;
            if (og + 1u == (tg + 1u) * nx) xb_add(&bar[XB_TOPGEN], 1u);
            else XB_SPIN(xb_ld(&bar[XB_TOPGEN]) == tg, bar);
            __builtin_amdgcn_fence(__ATOMIC_ACQUIRE, "agent");
            xb_add(&bar[XB_XGEN(b.x)], 1u);
            asm volatile("s_waitcnt vmcnt(0)" ::: "memory");
        } else {
            XB_SPIN(xb_ld(&bar[XB_XGEN(b.x)]) == gen, bar);
            __builtin_amdgcn_fence(__ATOMIC_ACQUIRE, "agent");
            asm volatile("s_waitcnt vmcnt(0)" ::: "memory");
        }
    }
    __syncthreads();
}

constexpr int SLOTS = 12, NPH = 1 + 4 * SLOTS;
__global__ void __launch_bounds__(NWAVES * 64, 2) yoco_fwd(Args args) {
    extern __shared__ __attribute__((aligned(16))) unsigned char lds_raw[];
    LAS unsigned char* lds = (LAS unsigned char*)lds_raw;
#if MK_ONE_LAUNCH
    cg::grid_group grid = cg::this_grid();
    volatile LAS unsigned* bst = (volatile LAS unsigned*)(lds + 131072 + 256);
    if (threadIdx.x < 2) bst[threadIdx.x] = 0u;
    __syncthreads();
    const XcdBarrier xbar = xcd_barrier_post((unsigned*)args.ws, bst);
#endif
    int again_ = 0;
    for (int ph = args.ph_lo; ph < args.ph_hi; ++ph) {
        bool did = true;
        __attribute__((address_space(1))) unsigned char* wsg_ = (__attribute__((address_space(1))) unsigned char*)args.ws;
        __attribute__((address_space(1))) float* outg_ = (__attribute__((address_space(1))) float*)args.out; int tid_ = threadIdx.x, bx_ = blockIdx.x;
        asm volatile("" : "+s"(wsg_), "+s"(outg_), "+v"(tid_), "+s"(bx_));
        unsigned char* ws = (unsigned char*)wsg_; float* out = (float*)outg_;
        Ctx C; C.lane = tid_ & 63; C.wave = __builtin_amdgcn_readfirstlane(tid_ >> 6); C.G = gridDim.x;
        { const int vcu = (C.G % 8 == 0) ? (bx_ % 8) * (C.G / 8) + bx_ / 8 : bx_; C.gw = vcu * NWAVES + C.wave; C.NGW = C.G * NWAVES; }
        const float *x_p = args.in[0], *x_s = args.in[1], *state = args.in[2], *cache_k = args.in[3], *cache_v = args.in[4], *norm_g = args.in[5];
        const float *w_gate = args.in[6], *w_up = args.in[7], *w_down = args.in[8], *p_win = args.in[9], *p_wgrp = args.in[10], *p_scale = args.in[11], *p_wout = args.in[12];
        const float *kv_norm = args.in[13], *w_k = args.in[14], *w_v = args.in[15], *a_wq = args.in[16], *a_wo = args.in[17];
        bf16_t* H = (bf16_t*)(ws + WS_H);   float* Rs = (float*)(ws + WS_R);   bf16_t* XN = (bf16_t*)(ws + WS_XN); bf16_t* XN2 = (bf16_t*)(ws + WS_XN2); bf16_t* ACT = (bf16_t*)(ws + WS_ACT);
        float* Fb = (float*)(ws + WS_F); float* Pb = (float*)(ws + WS_PART); bf16_t* OG = (bf16_t*)(ws + WS_OG); float* LSE = (float*)(ws + WS_LSE);
        bf16_t *KB = (bf16_t*)(ws + WS_KB), *VB = (bf16_t*)(ws + WS_VB), *KBS = (bf16_t*)(ws + WS_KBS), *VBS = (bf16_t*)(ws + WS_VBS);
        if (ph == 0) for (int rep_ = 0; rep_ < REP_PRO; ++rep_) {
            LAS float* scr = (LAS float*)(lds + C.wave * 16384);
            {
                const TrSrc TS{w_gate, w_up, w_down, p_win, w_k, w_v, a_wo, a_wq, norm_g, kv_norm, ws};
                for (int it = C.gw; it < TR_NITEMS; it += 2 * C.NGW) {
                    const int it1 = it + C.NGW; const bool h1 = it1 < TR_NITEMS;
                    TrJob j0, j1; float va[32], vb[32];
                    tr_decode(TS, it, j0); tr_decode(TS, h1 ? it1 : it, j1);
                    tr_load(j0, C.lane, va); tr_load(j1, C.lane, vb);
                    tr_finish(j0, C.lane, scr, va);
                    if (h1) tr_finish(j1, C.lane, scr, vb);
                }
            }
            for (int it = C.gw; it < 2 * 16 * 128; it += C.NGW) {
                const int kb = it & 127, nbk = (it >> 7) & 15, ly = it >> 11, k0 = kb * 8, g = k0 >> 8, n = nbk * 64 + C.lane;
                const float* G = p_wgrp + ((size_t)(ly * 4 + g) * 256 + (k0 & 255)) * 256;
                const float* S = p_scale + ly * D + g * 256; const float* WO = p_wout + ((size_t)ly * D + g * 256) * D + n;
                float a[8];
#pragma unroll
                for (int q = 0; q < 8; ++q) a[q] = 0.f;
#pragma unroll 2
                for (int j = 0; j < 256; j += 4) {
                    const f32x4 sc4 = *(const f32x4*)(S + j);
                    const float sv0 = sc4.x * WO[(size_t)j * D], sv1 = sc4.y * WO[(size_t)(j + 1) * D], sv2 = sc4.z * WO[(size_t)(j + 2) * D], sv3 = sc4.w * WO[(size_t)(j + 3) * D];
#pragma unroll
                    for (int q = 0; q < 8; ++q) { const f32x4 g4 = *(const f32x4*)(G + q * 256 + j); a[q] += (g4.x * sv0 + g4.y * sv1) + (g4.z * sv2 + g4.w * sv3); }
                }
                u32x4 o; o.x = pk2(a[0], a[1]); o.y = pk2(a[2], a[3]); o.z = pk2(a[4], a[5]); o.w = pk2(a[6], a[7]);
                *(u32x4*)((bf16_t*)(ws + WS_WEFF) + ((size_t)ly * D + n) * D + k0) = o;
            }
            const bool wincopy = (C.G == 256);
            if (wincopy) {
                constexpr int NEED = 1280, NIT = 2 * DB * NEED;
                for (int it0 = C.gw; it0 < NIT; it0 += 4 * C.NGW) {
                    f32x4 v[4][4]; bf16_t* bd[4]; bool ok[4];
#pragma unroll
                    for (int k = 0; k < 4; ++k) { const int itk = it0 + k * C.NGW; ok[k] = itk < NIT; const int it = ok[k] ? itk : it0;
                        const int e = it % NEED, pb = it / NEED, b = pb & 31, kv = pb >> 5, j = (e < 768) ? 16 * (e >> 3) + (e & 7) : e + 768;
                        const float* src = (kv ? cache_v : cache_k) + ((size_t)b * KVB + j) * D + 4 * C.lane; bd[k] = (kv ? VBS : KBS) + ((size_t)b * SROWS + j) * D + 4 * C.lane;
#pragma unroll
                        for (int q = 0; q < 4; ++q) v[k][q] = __builtin_nontemporal_load((const f32x4*)(src + 256 * q)); }
#pragma unroll
                    for (int k = 0; k < 4; ++k)
                        if (ok[k]) {
#pragma unroll
                            for (int q = 0; q < 4; ++q) { u32x2 w; w.x = pk2(v[k][q].x, v[k][q].y); w.y = pk2(v[k][q].z, v[k][q].w); *(u32x2*)(bd[k] + 256 * q) = w; }
                        }
                }
            } else
            for (int it = C.gw; it < 2 * DB * KVB; it += C.NGW) {
                const int j = it & (KVB - 1), b = (it >> 11) & 31, kv = it >> 16;
                const bool need = (j >= 1536) || ((j & 15) < 8);
                if (wincopy && !need) continue;
                const float* src = (kv ? cache_v : cache_k) + ((size_t)b * KVB + j) * D + 4 * C.lane;
                float* dst = out + (kv ? O_VS : O_KS) + ((size_t)b * KVB + (j - DT)) * D + 4 * C.lane;
                bf16_t* bd = (kv ? VBS : KBS) + ((size_t)b * SROWS + j) * D + 4 * C.lane;
#pragma unroll
                for (int q = 0; q < 4; ++q) { const f32x4 v = __builtin_nontemporal_load((const f32x4*)(src + 256 * q));
                    if (!wincopy && j >= DT) __builtin_nontemporal_store(v, (f32x4*)(dst + 256 * q));
                    if (need) { u32x2 w; w.x = pk2(v.x, v.y); w.y = pk2(v.z, v.w); *(u32x2*)(bd + 256 * q) = w; } }
            }
            norm_pass(C, 0, x_p, x_s, nullptr, nullptr, 1, nullptr, 0.f, H, norm_g, XN, nullptr, nullptr, nullptr, Rs);
        } else {
            const int l = (ph - 1) / SLOTS, slot = (ph - 1) % SLOTS;
            const bool pool = l < 2; const int j = l - 2;
            const float* gl = norm_g + (size_t)l * 6 * D;
            int gt = -1; const bf16_t* gA = nullptr; const bf16_t* gB = nullptr; int gN = 0, gK = 0, gS = 1; const float* gR = nullptr;
            const bool fuse = MK_ONE_LAUNCH && (C.G == 256);
            const float* np_gpost = nullptr; const float* np_gnext = nullptr; const float* np_gkv = nullptr; float np_alpha = 0.f; float* np_yout = nullptr; int fp = 0;
            switch (slot) {
                case 0: if (l == 2) { gt = 3; gA = H; gB = (const bf16_t*)(ws + WS_WKV); gN = 2 * D; gK = D; } else did = false; break;
                case 1: case 9: { const int li = l * 2 + (slot == 9); gt = 0; gA = H; gB = (const bf16_t*)(ws + WS_FFN + (size_t)li * FFN_STRIDE); gN = 2 * FF; gK = D; } break;
                case 2: case 10: { const int li = l * 2 + (slot == 10); gt = fuse ? 4 : 1; gA = ACT; gB = (const bf16_t*)(ws + WS_FFN + (size_t)li * FFN_STRIDE + WD_OFF); gN = D; gK = FF; gS = 22;
                    if (slot == 2) { np_gpost = gl + D; np_alpha = 0.5f; np_gnext = gl + 2 * D; fp = l * 3; }
                    else { np_gpost = gl + 5 * D; np_alpha = 0.5f; np_gnext = (l < 3) ? gl + 6 * D : gl; np_gkv = (l == 1) ? kv_norm : nullptr; np_yout = (l == 3) ? out : nullptr; fp = l * 3 + 2; } } break;
                case 3: if (fuse) norm_sample_wg<22>(tid_, C.wave, bx_, (LAS float*)(lds + XL_OFF), Pb, gl + D, 0.5f, H, gl + 2 * D, XN, nullptr, nullptr, nullptr, Rs);
                        else norm_pass(C, 1, nullptr, nullptr, Fb, Pb, 22, gl + D, 0.5f, H, gl + 2 * D, XN, nullptr, nullptr, nullptr, Rs, 0); break;
                case 4: if (pool) { gt = 5; gA = H; gB = (const bf16_t*)(ws + WS_WIN) + (size_t)l * D * D; gN = D; gK = D; gS = 8; }
                        else { gt = 2; gA = H; gB = (const bf16_t*)(ws + WS_WQ) + (size_t)j * NQ * D; gN = NQ; gK = D; } break;
                case 5: if (pool) pool_pass(C, l, (const bf16_t*)Fb, Pb, 8, state, XN2, out); else for (int rep_ = 0; rep_ < REP_ATTN; ++rep_) attn_phase(C, again_ ? PROBE_AMODE : 3, bx_, lds, ACT, KB, VB, KBS, VBS, OG, LSE); break;
                case 6: if (!pool) combine_pass(C, OG, LSE, XN2); else did = false; break;
                case 7: gt = fuse ? 4 : 1; np_gpost = gl + 3 * D; np_alpha = 1.0f; np_gnext = gl + 4 * D; fp = l * 3 + 1; gA = XN2; gB = pool ? (const bf16_t*)(ws + WS_WEFF) + (size_t)l * D * D : (const bf16_t*)(ws + WS_WO) + (size_t)j * D * D; gN = D; gK = D; gS = 8; break;
                case 8: if (fuse) norm_sample_wg<8>(tid_, C.wave, bx_, (LAS float*)(lds + XL_OFF), Pb, gl + 3 * D, 1.0f, H, gl + 4 * D, XN, nullptr, nullptr, nullptr, Rs);
                        else norm_pass(C, 1, nullptr, nullptr, Fb, Pb, 8, gl + 3 * D, 1.0f, H, gl + 4 * D, XN, nullptr, nullptr, nullptr, Rs, 0); break;
                case 11: if (fuse) norm_sample_wg<22>(tid_, C.wave, bx_, (LAS float*)(lds + XL_OFF), Pb, gl + 5 * D, 0.5f, H, (l < 3) ? gl + 6 * D : gl, XN, (l == 1) ? kv_norm : nullptr, XN2, (l == 3) ? out : nullptr, Rs);
                         else norm_pass(C, 1, nullptr, nullptr, Fb, Pb, 22, gl + 5 * D, 0.5f, H, (l < 3) ? gl + 6 * D : gl, XN, (l == 1) ? kv_norm : nullptr, XN2, (l == 3) ? out : nullptr, Rs, 0); break;
                default: break;
            }
            if (gt >= 0) for (int rep_ = 0; rep_ < REP_GEMM; ++rep_) {
                pg8::Sched S; S.init(gA, gB, gN, gK, gS, C.G, bx_); S.sfirst = (gt == 4) ? 1 : 0;
                if (gt == 0) { pg8::EpiSwiglu E{ACT, Rs}; pg8::gemm_phase(lds, S, E, tid_); }
                else if (gt == 1) { pg8::EpiF32 E{Fb, Pb, gR}; pg8::gemm_phase(lds, S, E, tid_); }
                else if (gt == 5) { pg8::EpiU E{(bf16_t*)Fb, Pb, Rs, out + O_PP + (size_t)l * NB * 15 * D}; pg8::gemm_phase(lds, S, E, tid_); }
                else if (gt == 2) { pg8::EpiQ E{ACT, 0.125f * 1.4426950408889634f, Rs}; pg8::gemm_phase(lds, S, E, tid_); }
                else if (gt == 4) {
                    unsigned* cntw = (unsigned*)(ws + WS_CNT);
                    PanelEx e1{(unsigned*)(ws + WS_X1), cntw, 32u * (unsigned)(2 * fp + 1)}, e2{(unsigned*)(ws + WS_X2), cntw, 32u * (unsigned)(2 * fp + 2)};
                    EpiNorm E{Pb, H, np_gpost, np_alpha, np_gnext, XN, np_gkv, XN2, np_yout, e1, e2, lds + XL_OFF, tid_, Rs}; pg8::gemm_phase(lds, S, E, tid_); }
                else { pg8::EpiKV E{out + O_KP, out + O_VP, out + O_KS, out + O_VS, KB, VB, KBS, VBS, Rs}; pg8::gemm_phase(lds, S, E, tid_); }
                if (C.G == 256 && !again_) {
                    int c0 = -1, lo = 0, cnt = 0;
                    if (slot == 1 || slot == 9) { c0 = 150; cnt = CP_Q_UG; lo = (l * 2 + (slot == 9)) * CP_Q_UG; }
                    else if (slot == 4 && !pool) { c0 = 12; cnt = CP_Q_WQ; lo = 8 * CP_Q_UG + j * CP_Q_WQ; }
                    else if (slot == 0) { c0 = 8; cnt = CP_Q_KV; lo = 8 * CP_Q_UG + 2 * CP_Q_WQ; }
                    if (c0 >= 0 && bx_ >= c0) copy_rows(C.lane, (bx_ - c0) * NWAVES + C.wave, (256 - c0) * NWAVES, lo, cnt, cache_k, cache_v, out);
                }
            }
        }
#if MK_ONE_LAUNCH
        if (did && ph + 1 < args.ph_hi) { if (ph == 0) grid.sync(); else xcd_barrier(xbar); }
        if (PROBE_SLOT >= 0 && ph > 0 && (ph - 1) % SLOTS == PROBE_SLOT && (ph - 1) / SLOTS >= PROBE_LMIN && (ph - 1) / SLOTS <= PROBE_LMAX && !again_) { again_ = 1; --ph; } else again_ = 0;
#endif
    }
}

extern "C" void kernel_launch(void* const* d_in, const int* in_sizes, int n_in, void* d_out, int out_size, void* d_ws, size_t ws_size, hipStream_t stream) {
    static int grid = 0;
    if (grid == 0) {
        if (n_in != 18 || ws_size < WS_END) { fprintf(stderr, "kernel_launch: unexpected inputs (n_in %d, ws %zu < %zu)\n", n_in, ws_size, (size_t)WS_END); grid = -1; return; }
        int dev = 0, cus = 0;
        if (hipGetDevice(&dev) != hipSuccess || hipDeviceGetAttribute(&cus, hipDeviceAttributeMultiprocessorCount, dev) != hipSuccess) { grid = -1; return; }
        if (hipFuncSetAttribute((const void*)yoco_fwd, hipFuncAttributeMaxDynamicSharedMemorySize, LDS_BYTES) != hipSuccess) { fprintf(stderr, "kernel_launch: hipFuncSetAttribute failed\n"); grid = -1; return; }
        int per_cu = 0;
        if (hipOccupancyMaxActiveBlocksPerMultiprocessor(&per_cu, (const void*)yoco_fwd, NWAVES * 64, LDS_BYTES) != hipSuccess || per_cu < 1) { fprintf(stderr, "kernel_launch: occupancy query says %d\n", per_cu); per_cu = 1; }
        (void)hipGetLastError();
        grid = cus;
    }
    if (grid < 0) return;
#if MK_ONE_LAUNCH
    if (hipMemsetAsync(d_ws, 0, 32768, stream) != hipSuccess) { fprintf(stderr, "kernel_launch: memset failed\n"); return; }
#endif
    Args a{};
    for (int i = 0; i < 18; ++i) a.in[i] = (const float*)d_in[i];
    a.out = (float*)d_out; a.ws = (unsigned char*)d_ws;
#if MK_ONE_LAUNCH
    a.ph_lo = 0; a.ph_hi = NPH;
    void* kargs[] = {&a};
    hipError_t e = hipLaunchCooperativeKernel((const void*)yoco_fwd, dim3(grid), dim3(NWAVES * 64), kargs, LDS_BYTES, stream);
    if (e != hipSuccess) fprintf(stderr, "kernel_launch: cooperative launch failed: %s (grid %d)\n", hipGetErrorString(e), grid);
#else
    for (int ph = 0; ph < NPH; ++ph) {
        if (ph > 0) { const int l = (ph - 1) / SLOTS, slot = (ph - 1) % SLOTS; if ((slot == 0 && l != 2) || (slot == 6 && l < 2)) continue; }
        a.ph_lo = ph; a.ph_hi = ph + 1;
        hipLaunchKernelGGL(yoco_fwd, dim3(grid), dim3(NWAVES * 64), LDS_BYTES, stream, a);
    }
#endif
}
```

```cpp
#include <hip/hip_runtime.h>
#include <hip/hip_cooperative_groups.h>
#include <cstdio>
#include <cstdint>
namespace cg = cooperative_groups;

#ifndef REP_GEMM
#define REP_GEMM 1
#endif
#ifndef REP_ATTN
#define REP_ATTN 1
#endif
#ifndef REP_PRO
#define REP_PRO 1
#endif
#ifndef PROBE_SLOT
#define PROBE_SLOT -1
#endif
#ifndef PROBE_LMIN
#define PROBE_LMIN 0
#endif
#ifndef PROBE_LMAX
#define PROBE_LMAX 3
#endif
#ifndef PROBE_AMODE
#define PROBE_AMODE 3
#endif
#ifndef MK_ONE_LAUNCH
#define MK_ONE_LAUNCH 1
#endif

#define LAS __attribute__((address_space(3)))
typedef unsigned short bf16_t;
typedef short bf16x8 __attribute__((ext_vector_type(8)));
typedef short s16x4 __attribute__((ext_vector_type(4)));
typedef float f32x4 __attribute__((ext_vector_type(4)));
typedef float f32x2 __attribute__((ext_vector_type(2)));
typedef float f32x16 __attribute__((ext_vector_type(16)));
typedef unsigned u32x4 __attribute__((ext_vector_type(4)));
typedef unsigned u32x2 __attribute__((ext_vector_type(2)));
typedef __bf16 bf16v2 __attribute__((ext_vector_type(2)));

__device__ __forceinline__ unsigned pk2(float lo, float hi) { f32x2 v = {lo, hi}; bf16v2 r = __builtin_convertvector(v, bf16v2); return __builtin_bit_cast(unsigned, r); }
__device__ __forceinline__ float bf_lo(unsigned w) { return __uint_as_float(w << 16); }
__device__ __forceinline__ float bf_hi(unsigned w) { return __uint_as_float(w & 0xffff0000u); }
__device__ __forceinline__ f32x4 ld_bf4(const bf16_t* p) { const u32x2 w = *(const u32x2*)p; return (f32x4){bf_lo(w.x), bf_hi(w.x), bf_lo(w.y), bf_hi(w.y)}; }
__device__ __forceinline__ void st_bf4(bf16_t* p, const f32x4 v) { u32x2 w; w.x = pk2(v.x, v.y); w.y = pk2(v.z, v.w); *(u32x2*)p = w; }

constexpr int D = 1024, FF = 2816, MP = 16384, MS = 256, M = MP + MS, SEQ = 2048, NB = 8, DB = 32, DT = 8, KVB = 2048, SROWS = KVB + DT;
constexpr int NH = 16, HD = 64, NQ = 3 * D;
constexpr float EPS = 1e-6f;
constexpr size_t O_YP = 0, O_YS = 16777216, O_PP = 17039360, O_KP = 17285120, O_VP = 34062336, O_PS = 50839552, O_KS = 51822592, O_VS = 118931456;
constexpr size_t MiB = 1u << 20;
constexpr size_t WS_FFN = 1 * MiB;
constexpr size_t FFN_STRIDE = 17301504, WD_OFF = 11534336;
constexpr size_t WS_WIN = 133 * MiB, WS_WEFF = 137 * MiB, WS_WKV = 141 * MiB, WS_WQ = 145 * MiB, WS_WO = 157 * MiB;
constexpr size_t WS_H = 161 * MiB;
constexpr size_t WS_XN = 226 * MiB;
constexpr size_t WS_XN2 = WS_XN + 34078720;
constexpr size_t WS_ACT = 291 * MiB;
constexpr size_t WS_F = WS_ACT + 102236160;
constexpr size_t WS_PART = WS_F + 68157440;
constexpr size_t WS_OG = WS_PART + 22 * MiB + MiB / 2;
constexpr size_t WS_LSE = WS_OG + 102236160;
constexpr size_t WS_KB = 577 * MiB, WS_VB = 609 * MiB;
constexpr size_t WS_KBS = 641 * MiB;
constexpr size_t WS_VBS = WS_KBS + 134742016;
constexpr size_t WS_END = WS_VBS + 134742016;
static_assert(WS_LSE + 3 * (size_t)M * 16 * 4 <= WS_KB, "ws map");

constexpr int LDS_BYTES = 147456;
constexpr int NWAVES = 8;

namespace pg8 {
constexpr int BM = 256, BK = 64, HALF = 128, HTB = HALF * BK * 2, STAGE_BYTES = 8 * HTB;
__device__ __forceinline__ int lds_byte(int r, int c) { const int st = (r >> 4) * 2 + (c >> 5), rr = r & 15, cc = c & 31, ob = rr * 64 + cc * 2; return st * 1024 + (ob ^ (((ob >> 9) & 1) << 5)); }
__device__ __forceinline__ void stage_rc(int b, int& R, int& C) { const int st = b / 1024, sb = b % 1024, swz = sb ^ (((sb >> 9) & 1) << 5); R = (st >> 1) * 16 + swz / 64; C = (st & 1) * 32 + (swz % 64) / 2; }
__device__ __forceinline__ int perm32(int rho) { const int n = rho >> 4, i = rho & 15; return 8 * (i >> 2) + 4 * n + (i & 3); }

struct Unit { const char* A; const char* B; int nt, pm, pn, ks; };

struct Sched {
    const char* A; const char* Bt; int ld, nN, nwgP, G, c, nsplit, ntf;
    __device__ __forceinline__ void init(const bf16_t* A_, const bf16_t* Bt_, int N, int K, int nsplit_, int G_, int c_) {
        A = (const char*)A_; Bt = (const char*)Bt_; ld = K; nN = N / BM; nwgP = 64 * nN; G = G_; c = c_; nsplit = nsplit_; ntf = K / BK; }
    int sfirst = 0;
    __device__ __forceinline__ bool next(int i, Unit& u) const {
        long L = (long)i * G + c; const size_t tstep = (size_t)BM * ld * 2;
        if (sfirst) { const bool hasS = c < nN * nsplit; if (i > (hasS ? 1 : 0)) return false; L = (hasS && i == 0) ? (long)nwgP + c : (long)c; }
        if (L < nwgP) {
            int wgid = (int)L; { const int q = nwgP / 8, xcd = wgid % 8, off = wgid / 8; wgid = xcd * q + off; }
            const int nig = 8 * nN, gid = wgid / nig, fm = gid * 8;
            u.pm = fm + ((wgid % nig) % 8); u.pn = (wgid % nig) / 8; u.ks = 0; u.nt = ntf;
            u.A = A + (size_t)u.pm * tstep; u.B = Bt + (size_t)u.pn * tstep; return true;
        }
        L -= nwgP; if (L >= (long)nN * nsplit) return false;
        u.pm = 64; u.pn = (int)(L % nN); u.ks = (int)(L / nN); u.nt = ntf / nsplit;
        const size_t koff = (size_t)u.ks * u.nt * (BK * 2);
        u.A = A + 64 * tstep + koff; u.B = Bt + (size_t)u.pn * tstep + koff; return true;
    }
};

__device__ __forceinline__ float row_scale(const float* R, int row) { const f32x4 q = *(const f32x4*)(R + 4 * (size_t)row); return __builtin_amdgcn_rsqf(((q.x + q.y) + (q.z + q.w)) * (1.0f / 1024.0f) + 1e-6f); }
__device__ __forceinline__ float silu_mul(float g, float u) { return g * u * __builtin_amdgcn_rcpf(1.0f + __expf(-g)); }

struct EpiSwiglu {
    static constexpr bool PERM = true, AFTER_DRAIN = false;
    bf16_t* O; const float* R;
    __device__ __forceinline__ void operator()(const f32x4 (&acc)[2][2][4][2], const Unit& u, int wr, int wc, int fr, int fq) const {
        asm volatile("" : "+v"(fr), "+v"(fq));
        const int col0 = u.pn * HALF + wc * 32 + 8 * fq;
#pragma unroll
        for (int ai = 0; ai < 2; ++ai)
#pragma unroll
            for (int m = 0; m < 4; ++m) {
                const int grow = u.pm * BM + ai * HALF + wr * 64 + m * 16 + fr; const float rs = row_scale(R, grow);
                bf16_t* rowp = O + (size_t)grow * FF + col0;
                const f32x4 g0 = acc[ai][0][m][0] * rs, g1 = acc[ai][0][m][1] * rs, u0 = acc[ai][1][m][0] * rs, u1 = acc[ai][1][m][1] * rs;
                u32x4 w;
                w.x = pk2(silu_mul(g0[0], u0[0]), silu_mul(g0[1], u0[1])); w.y = pk2(silu_mul(g0[2], u0[2]), silu_mul(g0[3], u0[3]));
                w.z = pk2(silu_mul(g1[0], u1[0]), silu_mul(g1[1], u1[1])); w.w = pk2(silu_mul(g1[2], u1[2]), silu_mul(g1[3], u1[3]));
                *(u32x4*)rowp = w;
            }
    }
};
struct EpiQ {
    static constexpr bool PERM = true, AFTER_DRAIN = false;
    bf16_t* O; float scale; const float* R;
    __device__ __forceinline__ void operator()(const f32x4 (&acc)[2][2][4][2], const Unit& u, int wr, int wc, int fr, int fq) const {
        asm volatile("" : "+v"(fr), "+v"(fq));
        const int col0 = u.pn * BM + wc * 32 + 8 * fq;
#pragma unroll
        for (int ai = 0; ai < 2; ++ai)
#pragma unroll
            for (int m = 0; m < 4; ++m) {
                const int grow = u.pm * BM + ai * HALF + wr * 64 + m * 16 + fr; const float rs = scale * row_scale(R, grow);
                bf16_t* rowp = O + (size_t)grow * NQ + col0;
#pragma unroll
                for (int bj = 0; bj < 2; ++bj) { const f32x4 v0 = acc[ai][bj][m][0] * rs, v1 = acc[ai][bj][m][1] * rs;
                    u32x4 w; w.x = pk2(v0[0], v0[1]); w.y = pk2(v0[2], v0[3]); w.z = pk2(v1[0], v1[1]); w.w = pk2(v1[2], v1[3]);
                    *(u32x4*)(rowp + bj * HALF) = w; }
            }
    }
};
struct EpiF32 {
    static constexpr bool PERM = false, AFTER_DRAIN = false;
    float* F; float* P; const float* R;
    __device__ __forceinline__ void operator()(const f32x4 (&acc)[2][2][4][2], const Unit& u, int wr, int wc, int fr, int fq) const {
        asm volatile("" : "+v"(fr), "+v"(fq));
        float* base = (u.pm < 64) ? F + (size_t)u.pm * BM * D : P + (size_t)u.ks * BM * D;
        const int col0 = u.pn * BM + wc * 32 + 4 * fq;
#pragma unroll
        for (int ai = 0; ai < 2; ++ai)
#pragma unroll
            for (int m = 0; m < 4; ++m) {
                const int lrow = ai * HALF + wr * 64 + m * 16 + fr; const float rs = R ? row_scale(R, u.pm * BM + lrow) : 1.0f;
                float* rowp = base + (size_t)lrow * D + col0;
#pragma unroll
                for (int bj = 0; bj < 2; ++bj)
#pragma unroll
                    for (int n = 0; n < 2; ++n) *(f32x4*)(rowp + bj * HALF + n * 16) = acc[ai][bj][m][n] * rs;
                asm volatile("" ::: "memory");
            }
    }
};
struct EpiKV {
    static constexpr bool PERM = false, AFTER_DRAIN = false;
    float *oKp, *oVp, *oKs, *oVs; bf16_t *KB, *VB, *KBS, *VBS; const float* R;
    __device__ __forceinline__ void operator()(const f32x4 (&acc)[2][2][4][2], const Unit& u, int wr, int wc, int fr, int fq) const {
        asm volatile("" : "+v"(fr), "+v"(fq));
        const bool isV = u.pn >= 4; const int col0 = (u.pn & 3) * BM + wc * 32 + 4 * fq;
#pragma unroll
        for (int ai = 0; ai < 2; ++ai)
#pragma unroll
            for (int m = 0; m < 4; ++m) {
                const int lrow = ai * HALF + wr * 64 + m * 16 + fr; float* fo; bf16_t* bo; const float rs = row_scale(R, u.pm * BM + lrow);
                if (u.pm < 64) { const size_t g = (size_t)(u.pm * BM + lrow) * D; fo = (isV ? oVp : oKp) + g; bo = (isV ? VB : KB) + g; }
                else { const int b = lrow >> 3, t = lrow & 7; fo = (isV ? oVs : oKs) + ((size_t)b * KVB + (KVB - DT) + t) * D; bo = (isV ? VBS : KBS) + ((size_t)b * SROWS + KVB + t) * D; }
#pragma unroll
                for (int bj = 0; bj < 2; ++bj)
#pragma unroll
                    for (int n = 0; n < 2; ++n) { const f32x4 v = acc[ai][bj][m][n] * rs; const int c = col0 + bj * HALF + n * 16;
                        *(f32x4*)(fo + c) = v; u32x2 w; w.x = pk2(v[0], v[1]); w.y = pk2(v[2], v[3]); *(u32x2*)(bo + c) = w; }
                asm volatile("" ::: "memory");
            }
    }
};

template <class Epi>
__device__ __forceinline__ void gemm_phase(LAS unsigned char* lds, const Sched& S, const Epi& E, int tid) {
    const int wid = __builtin_amdgcn_readfirstlane(tid >> 6), lane = tid & 63, wr = wid >> 2, wc = wid & 3, fr = lane & 15, fq = lane >> 4;
    const int ld = S.ld;
    unsigned voffA[2], voffB[2];
#pragma unroll
    for (int i = 0; i < 2; ++i) { int R, C; stage_rc(tid * 16 + i * 8192, R, C); const int Rb = Epi::PERM ? ((R & ~31) + perm32(R & 31)) : R;
        voffA[i] = (unsigned)(R * ld + C) * 2u; voffB[i] = (unsigned)(Rb * ld + C) * 2u; }
    const size_t kstep = (size_t)(BK * 2);
    const size_t hstep = (size_t)HALF * ld * 2;
    const unsigned ldsw = (unsigned)wid * 1024u;
    const int aoff = lds_byte(wr * 64 + fr, fq * 8), boff = lds_byte(wc * 32 + fr, fq * 8);
#define PG8_SA(b, h) (((b) * 2 + (h)) * HTB)
#define PG8_SB(b, h) ((4 + (b) * 2 + (h)) * HTB)
#define PG8_STAGE(bufoff, gbase, voff) do { _Pragma("unroll") for (int _i = 0; _i < 2; ++_i) \
        __builtin_amdgcn_global_load_lds((const unsigned*)((const char*)(gbase) + (voff)[_i]), (LAS unsigned*)(lds + (bufoff) + ldsw + _i * 8192), 16, 0, 0); } while (0)
#define PG8_LDA(dst, b, h) do { _Pragma("unroll") for (int m = 0; m < 4; ++m) _Pragma("unroll") for (int k = 0; k < 2; ++k) dst[m][k] = *(const LAS bf16x8*)(lds + PG8_SA(b, h) + aoff + m * 2048 + k * 1024); } while (0)
#define PG8_LDB(dst, b, h) do { _Pragma("unroll") for (int n = 0; n < 2; ++n) _Pragma("unroll") for (int k = 0; k < 2; ++k) dst[n][k] = *(const LAS bf16x8*)(lds + PG8_SB(b, h) + boff + n * 2048 + k * 1024); } while (0)
#define PG8_MMA(ai, bj, At, Bt) do { __builtin_amdgcn_s_setprio(1); _Pragma("unroll") for (int m = 0; m < 4; ++m) _Pragma("unroll") for (int n = 0; n < 2; ++n) _Pragma("unroll") for (int k = 0; k < 2; ++k) \
        acc[ai][bj][m][n] = __builtin_amdgcn_mfma_f32_16x16x32_bf16(Bt[n][k], At[m][k], acc[ai][bj][m][n], 0, 0, 0); __builtin_amdgcn_s_setprio(0); } while (0)
#define PG8_WAIT_V(n) asm volatile("s_waitcnt vmcnt(" #n ")" ::: "memory")
#define PG8_WAIT_L(n) asm volatile("s_waitcnt lgkmcnt(" #n ")" ::: "memory")
#define PG8_BAR __builtin_amdgcn_s_barrier()
#define PG8_SCHED __builtin_amdgcn_sched_barrier(0)
    Unit cur, nxt; int ui = 0;
    if (!S.next(0, cur)) return;
    f32x4 acc[2][2][4][2];
#pragma unroll
    for (int a = 0; a < 2; ++a)
#pragma unroll
        for (int b = 0; b < 2; ++b)
#pragma unroll
            for (int m = 0; m < 4; ++m)
#pragma unroll
                for (int n = 0; n < 2; ++n) acc[a][b][m][n] = (f32x4){0.f, 0.f, 0.f, 0.f};
    bf16x8 At[4][2], B0[2][2], B1[2][2];
    const char* cA = cur.A; const char* cB = cur.B;
    PG8_STAGE(PG8_SB(0, 0), cB, voffB); PG8_STAGE(PG8_SB(0, 1), cB + hstep, voffB); PG8_STAGE(PG8_SA(0, 0), cA, voffA); PG8_STAGE(PG8_SA(0, 1), cA + hstep, voffA);
    if (wr == 1) PG8_BAR;
    PG8_WAIT_V(2); PG8_BAR;
    PG8_STAGE(PG8_SB(1, 0), cB + kstep, voffB); PG8_STAGE(PG8_SA(1, 0), cA + kstep, voffA); PG8_STAGE(PG8_SB(1, 1), cB + hstep + kstep, voffB);
    PG8_WAIT_V(6); PG8_BAR;
    for (;;) {
        const bool has_next = S.next(ui + 1, nxt);
        const char* nA = has_next ? nxt.A : cA; const char* nB = has_next ? nxt.B : cB;
        const int nt = cur.nt;
        for (int t = 0; t < nt; t += 2) {
            const bool last = (t == nt - 2);
            const char* a1 = cA + (size_t)(t + 1) * kstep;
            const char* a2 = last ? nA : cA + (size_t)(t + 2) * kstep; const char* b2 = last ? nB : cB + (size_t)(t + 2) * kstep;
            const char* a3 = a2 + kstep; const char* b3 = b2 + kstep;
            PG8_LDB(B0, 0, 0); PG8_LDB(B1, 0, 1); PG8_SCHED; PG8_LDA(At, 0, 0); PG8_STAGE(PG8_SA(1, 1), a1 + hstep, voffA);
            PG8_WAIT_V(8); PG8_WAIT_L(0); PG8_BAR; PG8_MMA(0, 0, At, B0); PG8_MMA(0, 1, At, B1); PG8_BAR; PG8_SCHED;
            PG8_LDA(At, 0, 1); PG8_STAGE(PG8_SB(0, 0), b2, voffB); PG8_STAGE(PG8_SB(0, 1), b2 + hstep, voffB); PG8_STAGE(PG8_SA(0, 0), a2, voffA);
            PG8_WAIT_V(8); PG8_WAIT_L(0); PG8_BAR; PG8_MMA(1, 0, At, B0); PG8_MMA(1, 1, At, B1); PG8_BAR; PG8_SCHED;
            PG8_LDB(B0, 1, 0); PG8_LDB(B1, 1, 1); PG8_SCHED; PG8_LDA(At, 1, 0); PG8_STAGE(PG8_SA(0, 1), a2 + hstep, voffA);
            PG8_WAIT_V(8); PG8_WAIT_L(0); PG8_BAR; PG8_MMA(0, 0, At, B0); PG8_MMA(0, 1, At, B1); PG8_BAR; PG8_SCHED;
            PG8_LDA(At, 1, 1); PG8_STAGE(PG8_SB(1, 0), b3, voffB); PG8_STAGE(PG8_SB(1, 1), b3 + hstep, voffB); PG8_STAGE(PG8_SA(1, 0), a3, voffA);
            PG8_WAIT_V(8); PG8_WAIT_L(0); PG8_BAR; PG8_MMA(1, 0, At, B0); PG8_MMA(1, 1, At, B1); PG8_BAR; PG8_SCHED;
        }
        if (wr == 0) PG8_BAR;
        if (!Epi::AFTER_DRAIN || has_next) E(acc, cur, wr, wc, fr, fq);
        if (!has_next) break;
#pragma unroll
        for (int a = 0; a < 2; ++a)
#pragma unroll
            for (int b = 0; b < 2; ++b)
#pragma unroll
                for (int m = 0; m < 4; ++m)
#pragma unroll
                    for (int n = 0; n < 2; ++n) acc[a][b][m][n] = (f32x4){0.f, 0.f, 0.f, 0.f};
        cur = nxt; cA = nA; cB = nB; ++ui;
        if (wr == 1) PG8_BAR;
    }
    PG8_WAIT_V(0);
    PG8_BAR;
    if constexpr (Epi::AFTER_DRAIN) E.fused(acc, cur, wr, wc, fr, fq);
#undef PG8_SA
#undef PG8_SB
#undef PG8_STAGE
#undef PG8_LDA
#undef PG8_LDB
#undef PG8_MMA
#undef PG8_WAIT_V
#undef PG8_WAIT_L
#undef PG8_BAR
#undef PG8_SCHED
}
}

struct Args { const float* in[18]; float* out; unsigned char* ws; int ph_lo, ph_hi; };
struct Ctx { int lane, wave, gw, NGW, G; };

__device__ __forceinline__ float lane_xor(float v, int lane, int mask) { return __int_as_float(__builtin_amdgcn_ds_bpermute((lane ^ mask) << 2, __float_as_int(v))); }
__device__ __forceinline__ float wave_sum(float v, int lane) {
#pragma unroll
    for (int o = 1; o < 64; o <<= 1) v += lane_xor(v, lane, o);
    return v;
}
__device__ __forceinline__ float ss4(const f32x4 v) { return (v.x * v.x + v.y * v.y) + (v.z * v.z + v.w * v.w); }

constexpr size_t WS_CNT = 16384, WS_X1 = 65536, WS_X2 = 65536 + 262144, WS_R = 655360;
constexpr int XL_OFF = 131072 + 1024;
struct PanelEx {
    unsigned* xbuf; unsigned* cnt; unsigned want;
    __device__ __forceinline__ void run(const float (&part)[2][4], const pg8::Unit& u, int wr, int wc, int fr, int fq, LAS unsigned char* xl, int wid, int lane) const {
        LAS float* P = (LAS float*)xl; LAS float* S = (LAS float*)(xl + 4096);
#pragma unroll
        for (int ai = 0; ai < 2; ++ai)
#pragma unroll
            for (int m = 0; m < 4; ++m) { float sq = part[ai][m]; sq += lane_xor(sq, lane, 16); sq += lane_xor(sq, lane, 32);
                if (fq == 0) P[(ai * 128 + wr * 64 + m * 16 + fr) * 4 + wc] = sq; }
        asm volatile("s_waitcnt lgkmcnt(0)" ::: "memory"); __builtin_amdgcn_s_barrier(); asm volatile("" ::: "memory");
        const int row = wid * 32 + (lane & 31);
        if (lane < 32) { const float t = (P[row * 4 + 0] + P[row * 4 + 1]) + (P[row * 4 + 2] + P[row * 4 + 3]);
            __hip_atomic_store(xbuf + (size_t)(u.pm * 256 + row) * 4 + u.pn, __float_as_uint(t), __ATOMIC_RELAXED, __HIP_MEMORY_SCOPE_AGENT); }
        asm volatile("s_waitcnt vmcnt(0)" ::: "memory");
        if (lane == 0) __hip_atomic_fetch_add(cnt + 64 * u.pm, 1u, __ATOMIC_RELAXED, __HIP_MEMORY_SCOPE_AGENT);
        if (wid == 0) {
            unsigned sp = 0;
            while ((unsigned)__builtin_amdgcn_readfirstlane(__hip_atomic_load(cnt + 64 * u.pm, __ATOMIC_RELAXED, __HIP_MEMORY_SCOPE_AGENT)) < want) { __builtin_amdgcn_s_sleep(2); if (++sp > (1u << 22)) break; }
            __builtin_amdgcn_fence(__ATOMIC_ACQUIRE, "agent");
        }
        asm volatile("s_waitcnt vmcnt(0) lgkmcnt(0)" ::: "memory"); __builtin_amdgcn_s_barrier(); asm volatile("" ::: "memory");
        if (lane < 32) { const unsigned* sl = xbuf + (size_t)(u.pm * 256 + row) * 4; float t = 0.f;
#pragma unroll
            for (int q = 0; q < 4; ++q) t += __uint_as_float(__hip_atomic_load(sl + q, __ATOMIC_RELAXED, __HIP_MEMORY_SCOPE_AGENT));
            S[row] = t; }
        asm volatile("s_waitcnt lgkmcnt(0)" ::: "memory"); __builtin_amdgcn_s_barrier(); asm volatile("" ::: "memory");
    }
};
struct EpiNorm {
    static constexpr bool PERM = false, AFTER_DRAIN = true;
    float* P; bf16_t* H; const float* gpost; float alpha; const float* gnext; bf16_t* XN; const float* gkv; bf16_t* XN2; float* yout;
    PanelEx e1; LAS unsigned char* xl; int tid; float* R;
    __device__ __forceinline__ void operator()(f32x4 (&acc)[2][2][4][2], const pg8::Unit& u, int wr, int wc, int fr, int fq) const {
        asm volatile("" : "+v"(fr), "+v"(fq));
        const int col0 = u.pn * 256 + wc * 32 + 4 * fq;
        if (u.pm >= 64) {
            float* base = P + (size_t)u.ks * 256 * D;
#pragma unroll
            for (int ai = 0; ai < 2; ++ai)
#pragma unroll
                for (int m = 0; m < 4; ++m) { float* rowp = base + (size_t)(ai * 128 + wr * 64 + m * 16 + fr) * D + col0;
#pragma unroll
                    for (int bj = 0; bj < 2; ++bj)
#pragma unroll
                        for (int n = 0; n < 2; ++n) *(f32x4*)(rowp + bj * 128 + n * 16) = acc[ai][bj][m][n];
                    asm volatile("" ::: "memory"); }
            return;
        }
    }
    __device__ __forceinline__ void fused(f32x4 (&acc)[2][2][4][2], const pg8::Unit& u, int wr, int wc, int fr, int fq) const {
        asm volatile("" : "+v"(fr), "+v"(fq));
        const int col0 = u.pn * 256 + wc * 32 + 4 * fq;
        int lane = tid & 63; asm volatile("" : "+v"(lane));
        const int wid = wr * 4 + wc;
        const LAS float* S = (const LAS float*)(xl + 4096);
        float part[2][4];
#pragma unroll
        for (int ai = 0; ai < 2; ++ai)
#pragma unroll
            for (int m = 0; m < 4; ++m) { float sq = 0.f;
#pragma unroll
                for (int bj = 0; bj < 2; ++bj)
#pragma unroll
                    for (int n = 0; n < 2; ++n) sq += ss4(acc[ai][bj][m][n]);
                part[ai][m] = sq; }
        u32x2 hraw[4][2][2];
#pragma unroll
        for (int m = 0; m < 4; ++m) { const bf16_t* hp = H + (size_t)(u.pm * 256 + wr * 64 + m * 16 + fr) * D + col0;
#pragma unroll
            for (int bj = 0; bj < 2; ++bj)
#pragma unroll
                for (int n = 0; n < 2; ++n) hraw[m][bj][n] = *(const u32x2*)(hp + bj * 128 + n * 16); }
        e1.run(part, u, wr, wc, fr, fq, xl, wid, lane);
        {
            f32x4 g[2][2];
#pragma unroll
            for (int bj = 0; bj < 2; ++bj)
#pragma unroll
                for (int n = 0; n < 2; ++n) g[bj][n] = *(const f32x4*)(gpost + col0 + bj * 128 + n * 16);
#pragma unroll
            for (int ai = 0; ai < 2; ++ai)
#pragma unroll
                for (int m = 0; m < 4; ++m) { const int r = ai * 128 + wr * 64 + m * 16 + fr; const float rf = alpha * __builtin_amdgcn_rsqf(S[r] * (1.0f / D) + EPS);
                    float sq = 0.f;
#pragma unroll
                    for (int bj = 0; bj < 2; ++bj)
#pragma unroll
                        for (int n = 0; n < 2; ++n) { const u32x2 hw = (ai == 0) ? hraw[m][bj][n] : *(const u32x2*)(H + (size_t)(u.pm * 256 + r) * D + col0 + bj * 128 + n * 16); const f32x4 ho = (f32x4){bf_lo(hw.x), bf_hi(hw.x), bf_lo(hw.y), bf_hi(hw.y)}; const f32x4 hn = ho + acc[ai][bj][m][n] * rf * g[bj][n]; acc[ai][bj][m][n] = hn; sq += ss4(hn); }
                    part[ai][m] = sq;
                    asm volatile("" : "+v"(acc[ai][0][m][0]), "+v"(acc[ai][0][m][1]), "+v"(acc[ai][1][m][0]), "+v"(acc[ai][1][m][1]), "+v"(part[ai][m]));
                    if (m & 1) asm volatile("" ::: "memory"); }
        }
        {
            LAS float* P = (LAS float*)xl;
#pragma unroll
            for (int ai = 0; ai < 2; ++ai)
#pragma unroll
                for (int m = 0; m < 4; ++m) { float sq = part[ai][m]; sq += lane_xor(sq, lane, 16); sq += lane_xor(sq, lane, 32);
                    if (fq == 0) P[(ai * 128 + wr * 64 + m * 16 + fr) * 4 + wc] = sq; }
            asm volatile("s_waitcnt lgkmcnt(0)" ::: "memory"); __builtin_amdgcn_s_barrier(); asm volatile("" ::: "memory");
            const int row = wid * 32 + (lane & 31);
            if (lane < 32 && !yout) R[(size_t)(u.pm * 256 + row) * 4 + u.pn] = (P[row * 4 + 0] + P[row * 4 + 1]) + (P[row * 4 + 2] + P[row * 4 + 3]);
        }
        {
#pragma unroll
            for (int ai = 0; ai < 2; ++ai)
#pragma unroll
                for (int m = 0; m < 4; ++m) { const int r = ai * 128 + wr * 64 + m * 16 + fr;
                    const size_t off = (size_t)(u.pm * 256 + r) * D + col0;
#pragma unroll
                    for (int bj = 0; bj < 2; ++bj)
#pragma unroll
                        for (int n = 0; n < 2; ++n) { const f32x4 hn = acc[ai][bj][m][n];
                            if (yout) *(f32x4*)(yout + O_YP + off + bj * 128 + n * 16) = hn; else st_bf4(H + off + bj * 128 + n * 16, hn); }
                    asm volatile("" ::: "memory"); }
        }
    }
};

struct TrJob { const float* W; bf16_t* WT; const float* gain; int K, N, mode, item; };
struct TrSrc { const float *w_gate, *w_up, *w_down, *p_win, *w_k, *w_v, *a_wo, *a_wq, *norm_g, *kv_norm; unsigned char* ws; };
constexpr int TR_I_FFN = 24 * 1408, TR_I_SQ = 6 * 512, TR_I_Q = 2 * 1536, TR_NITEMS = TR_I_FFN + TR_I_SQ + TR_I_Q;
__device__ __forceinline__ void tr_decode(const TrSrc& T, int it, TrJob& j) {
    int r = it;
    if (r < TR_I_FFN) { const int job = r / 1408, li = job / 3, kind = job % 3; j.item = r % 1408;
        bf16_t* dst = (bf16_t*)(T.ws + WS_FFN + (size_t)li * FFN_STRIDE);
        const float* gpre = T.norm_g + (size_t)((li >> 1) * 6 + ((li & 1) ? 4 : 0)) * D;
        if (kind == 0) { j.W = T.w_gate + (size_t)li * D * FF; j.K = D; j.N = FF; j.WT = dst; j.mode = 1; j.gain = gpre; }
        else if (kind == 1) { j.W = T.w_up + (size_t)li * D * FF; j.K = D; j.N = FF; j.WT = dst; j.mode = 2; j.gain = gpre; }
        else { j.W = T.w_down + (size_t)li * D * FF; j.K = FF; j.N = D; j.WT = (bf16_t*)((unsigned char*)dst + WD_OFF); j.mode = 0; j.gain = nullptr; }
        return; }
    r -= TR_I_FFN;
    if (r < TR_I_SQ) { const int job = r / 512; j.item = r % 512; j.K = D; j.N = D; j.mode = 0;
        if (job < 2) { j.W = T.p_win + (size_t)job * D * D; j.WT = (bf16_t*)(T.ws + WS_WIN) + (size_t)job * D * D; j.gain = T.norm_g + (size_t)(job * 6 + 2) * D; }
        else if (job == 2) { j.W = T.w_k; j.WT = (bf16_t*)(T.ws + WS_WKV); j.gain = T.kv_norm; }
        else if (job == 3) { j.W = T.w_v; j.WT = (bf16_t*)(T.ws + WS_WKV) + (size_t)D * D; j.gain = T.kv_norm; }
        else { j.W = T.a_wo + (size_t)(job - 4) * D * D; j.WT = (bf16_t*)(T.ws + WS_WO) + (size_t)(job - 4) * D * D; j.gain = nullptr; }
        return; }
    r -= TR_I_SQ;
    { const int job = r / 1536; j.item = r % 1536; j.K = D; j.N = NQ; j.mode = 0; j.W = T.a_wq + (size_t)job * D * NQ; j.WT = (bf16_t*)(T.ws + WS_WQ) + (size_t)job * NQ * D; j.gain = T.norm_g + (size_t)((2 + job) * 6 + 2) * D; }
}
__device__ __forceinline__ void tr_load(const TrJob& j, int lane, float (&v)[32]) {
    const int nblk = j.N / 32, kb = j.item / nblk, nb = j.item % nblk, k0 = 64 * kb, n0 = 32 * nb;
    const float* p = j.W + (size_t)(k0 + (lane >> 5)) * j.N + n0 + (lane & 31);
#pragma unroll
    for (int i = 0; i < 32; ++i) v[i] = __builtin_nontemporal_load(p + (size_t)(2 * i) * j.N);
}
__device__ __forceinline__ void tr_finish(const TrJob& j, int lane, LAS float* scr, const float (&v)[32]) {
    const int nblk = j.N / 32, kb = j.item / nblk, nb = j.item % nblk, k0 = 64 * kb, n0 = 32 * nb;
#pragma unroll
    for (int i = 0; i < 32; ++i) scr[(2 * i + (lane >> 5)) * 33 + (lane & 31)] = v[i];
    asm volatile("s_waitcnt lgkmcnt(0)" ::: "memory");
    const int orow0 = (j.mode == 0) ? n0 : ((n0 >> 7) * 256 + (n0 & 127) + (j.mode == 2 ? 128 : 0));
    const int c = lane & 7;
    f32x4 ga = {1.f, 1.f, 1.f, 1.f}, gb = {1.f, 1.f, 1.f, 1.f};
    if (j.gain) { ga = *(const f32x4*)(j.gain + k0 + 8 * c); gb = *(const f32x4*)(j.gain + k0 + 8 * c + 4); }
#pragma unroll
    for (int q = 0; q < 4; ++q) { const int n = (lane >> 3) + 8 * q; const LAS float* sp = scr + (8 * c) * 33 + n;
        u32x4 o; o.x = pk2(sp[0 * 33] * ga.x, sp[1 * 33] * ga.y); o.y = pk2(sp[2 * 33] * ga.z, sp[3 * 33] * ga.w); o.z = pk2(sp[4 * 33] * gb.x, sp[5 * 33] * gb.y); o.w = pk2(sp[6 * 33] * gb.z, sp[7 * 33] * gb.w);
        *(u32x4*)(j.WT + (size_t)(orow0 + n) * j.K + k0 + 8 * c) = o; }
    asm volatile("s_waitcnt lgkmcnt(0)" ::: "memory");
}

template <int NR>
__device__ __forceinline__ void norm_rows(int lane, int m0, int stride, int mode, const float* xp, const float* xs, const float* Fb, const float* Pb, int nsplit, const float* gpost, float alpha,
                                          bf16_t* H, const float* gnext, bf16_t* XN, const float* gkv, bf16_t* XN2, float* yout, float* R) {
    f32x4 h[NR][4]; size_t ro[NR];
#pragma unroll
    for (int k = 0; k < NR; ++k) ro[k] = (size_t)(m0 + k * stride) * D + 4 * lane;
    if (mode == 0) {
#pragma unroll
        for (int k = 0; k < NR; ++k) { const int m = m0 + k * stride; const float* src = (m < MP) ? xp + ro[k] : xs + (ro[k] - (size_t)MP * D);
#pragma unroll
            for (int j = 0; j < 4; ++j) h[k][j] = *(const f32x4*)(src + 256 * j); }
    } else {
        f32x4 f[NR][4];
#pragma unroll
        for (int k = 0; k < NR; ++k) { const int m = m0 + k * stride;
            if (m < MP) {
#pragma unroll
                for (int j = 0; j < 4; ++j) f[k][j] = *(const f32x4*)(Fb + ro[k] + 256 * j);
            } else {
                const float* p = Pb + (size_t)(m - MP) * D + 4 * lane;
#pragma unroll
                for (int j = 0; j < 4; ++j) f[k][j] = *(const f32x4*)(p + 256 * j);
                int s = 1;
                for (; s + 3 < nsplit; s += 4) {
                    f32x4 t[4][4];
#pragma unroll
                    for (int q = 0; q < 4; ++q)
#pragma unroll
                        for (int j = 0; j < 4; ++j) t[q][j] = *(const f32x4*)(p + (size_t)(s + q) * MS * D + 256 * j);
#pragma unroll
                    for (int j = 0; j < 4; ++j) f[k][j] += (t[0][j] + t[1][j]) + (t[2][j] + t[3][j]);
                }
                for (; s < nsplit; ++s) {
#pragma unroll
                    for (int j = 0; j < 4; ++j) f[k][j] += *(const f32x4*)(p + (size_t)s * MS * D + 256 * j);
                }
            }
#pragma unroll
            for (int j = 0; j < 4; ++j) h[k][j] = ld_bf4(H + ro[k] + 256 * j);
        }
        f32x4 g[4];
#pragma unroll
        for (int j = 0; j < 4; ++j) g[j] = *(const f32x4*)(gpost + 4 * lane + 256 * j);
#pragma unroll
        for (int k = 0; k < NR; ++k) {
            float ss = 0.f;
#pragma unroll
            for (int j = 0; j < 4; ++j) ss += ss4(f[k][j]);
            const float rf = alpha * __builtin_amdgcn_rsqf(wave_sum(ss, lane) * (1.0f / D) + EPS);
#pragma unroll
            for (int j = 0; j < 4; ++j) h[k][j] += f[k][j] * rf * g[j];
        }
    }
    float sq[NR];
#pragma unroll
    for (int k = 0; k < NR; ++k) {
        float ss = 0.f;
#pragma unroll
        for (int j = 0; j < 4; ++j) ss += ss4(h[k][j]);
        sq[k] = wave_sum(ss, lane);
    }
    if (yout) {
#pragma unroll
        for (int k = 0; k < NR; ++k) { const int m = m0 + k * stride; float* yo = (m < MP) ? yout + O_YP + ro[k] : yout + O_YS + (ro[k] - (size_t)MP * D);
#pragma unroll
            for (int j = 0; j < 4; ++j) *(f32x4*)(yo + 256 * j) = h[k][j]; }
    } else {
#pragma unroll
        for (int k = 0; k < NR; ++k) {
#pragma unroll
            for (int j = 0; j < 4; ++j) st_bf4(H + ro[k] + 256 * j, h[k][j]);
            if (lane == 0) *(f32x4*)(R + 4 * (size_t)(m0 + k * stride)) = (f32x4){sq[k], 0.f, 0.f, 0.f};
        }
    }
}
__device__ __forceinline__ void norm_pass(const Ctx& C0, int mode, const float* xp, const float* xs, const float* Fb, const float* Pb, int nsplit, const float* gpost, float alpha,
                                          bf16_t* H, const float* gnext, bf16_t* XN, const float* gkv, bf16_t* XN2, float* yout, float* R, int m_lo = 0) {
    Ctx C = C0; asm volatile("" : "+v"(C.lane));
    int m = m_lo + C.gw;
    for (; m + 3 * C.NGW < M; m += 4 * C.NGW) norm_rows<4>(C.lane, m, C.NGW, mode, xp, xs, Fb, Pb, nsplit, gpost, alpha, H, gnext, XN, gkv, XN2, yout, R);
    for (; m < M; m += C.NGW) norm_rows<1>(C.lane, m, C.NGW, mode, xp, xs, Fb, Pb, nsplit, gpost, alpha, H, gnext, XN, gkv, XN2, yout, R);
}

template <int NS>
__device__ __forceinline__ void norm_sample_wg(int tid_, int wave, int row, LAS float* red, const float* Pb, const float* gpost, float alpha, bf16_t* H, const float* gnext, bf16_t* XN,
                                               const float* gkv, bf16_t* XN2, float* yout, float* R) {
    int tid = tid_; asm volatile("" : "+v"(tid));
    const int lane = tid & 63, c = 2 * tid;
    const float* p = Pb + (size_t)row * D + c;
    f32x2 pv[NS];
#pragma unroll
    for (int q = 0; q < NS; ++q) pv[q] = *(const f32x2*)(p + (size_t)q * MS * D);
    const size_t ro = (size_t)(MP + row) * D + c;
    const unsigned hw = *(const unsigned*)(H + ro);
    const f32x2 g1 = *(const f32x2*)(gpost + c);
    f32x2 f = pv[0];
#pragma unroll
    for (int q = 1; q < NS; ++q) f += pv[q];
    float ss = wave_sum(f.x * f.x + f.y * f.y, lane);
    if (lane == 0) red[wave] = ss;
    __syncthreads();
    float tot = 0.f;
#pragma unroll
    for (int q = 0; q < 8; ++q) tot += red[q];
    const float rf = alpha * __builtin_amdgcn_rsqf(tot * (1.0f / D) + EPS);
    const f32x2 h = (f32x2){bf_lo(hw), bf_hi(hw)} + f * rf * g1;
    ss = wave_sum(h.x * h.x + h.y * h.y, lane);
    if (lane == 0) red[8 + wave] = ss;
    __syncthreads();
    tot = 0.f;
#pragma unroll
    for (int q = 0; q < 8; ++q) tot += red[8 + q];
    if (yout) { *(f32x2*)(yout + O_YS + (size_t)row * D + c) = h; }
    else { *(unsigned*)(H + ro) = pk2(h.x, h.y); if (tid == 0) *(f32x4*)(R + 4 * (size_t)(MP + row)) = (f32x4){tot, 0.f, 0.f, 0.f}; }
}

__device__ __forceinline__ void pool_pass(const Ctx& C0, int layer, const float* Fb, const float* Pb, int nsplit, const float* state, bf16_t* Z, float* out) {
    Ctx C = C0; asm volatile("" : "+v"(C.lane));
    const int NIT = NB * 64 * 4 + DB * 4;
    for (int it = C.gw; it < NIT; it += C.NGW) {
        if (it < NB * 64 * 4) {
            const int cgp = it & 3, chunk = (it >> 2) & 63, b = it >> 8, w = 2 << cgp, col = cgp * 256 + 4 * C.lane, t0 = chunk * 32;
            const float* U = Fb + (size_t)b * SEQ * D + col; bf16_t* Zb = Z + (size_t)b * SEQ * D + col;
            float* po = out + O_PP + ((size_t)(layer * NB + b) * 15) * D + col;
            f32x4 s = {0.f, 0.f, 0.f, 0.f};
            for (int j = 1; j < w; ++j) { const int t = t0 - j; if (t >= 0) s += *(const f32x4*)(U + (size_t)t * D); }
            for (int tb = t0; tb < t0 + 32; tb += 8) {
                f32x4 ua[8], ub[8];
#pragma unroll
                for (int q = 0; q < 8; ++q) { const int t = tb + q, tp = t - w + 1; ua[q] = *(const f32x4*)(U + (size_t)t * D); ub[q] = *(const f32x4*)(U + (size_t)(tp >= 0 ? tp : 0) * D); }
#pragma unroll
                for (int q = 0; q < 8; ++q) { const int t = tb + q, tp = t - w + 1; const f32x4 ut = ua[q];
                    s += ut;
                    const float rc = 1.0f / (float)((t + 1 < w) ? (t + 1) : w);
                    const f32x4 z = s * rc - ut;
                    u32x2 o; o.x = pk2(z.x, z.y); o.y = pk2(z.z, z.w); *(u32x2*)(Zb + (size_t)t * D) = o;
                    if (tp >= 0) s -= ub[q];
                    if (t >= SEQ - 15) *(f32x4*)(po + (size_t)(t - (SEQ - 15)) * D) = ut; }
            }
        } else {
            const int r = it - NB * 64 * 4, cgp = r & 3, b = r >> 2, w = 2 << cgp, col = cgp * 256 + 4 * C.lane;
            f32x4 ext[23];
            const float* st = state + ((size_t)(layer * DB + b) * 15) * D + col;
#pragma unroll
            for (int e = 0; e < 15; ++e) ext[e] = *(const f32x4*)(st + (size_t)e * D);
#pragma unroll
            for (int t = 0; t < 8; ++t) {
                const float* p = Pb + (size_t)(b * 8 + t) * D + col; f32x4 pa[8];
#pragma unroll
                for (int s = 0; s < 8; ++s) pa[s] = *(const f32x4*)(p + (size_t)s * MS * D);
                ext[15 + t] = ((pa[0] + pa[1]) + (pa[2] + pa[3])) + ((pa[4] + pa[5]) + (pa[6] + pa[7]));
            }
            bf16_t* Zb = Z + ((size_t)MP + b * 8) * D + col; float* po = out + O_PS + ((size_t)(layer * DB + b) * 15) * D + col;
            const float rc = 1.0f / (float)w;
#pragma unroll
            for (int t = 0; t < 8; ++t) {
                f32x4 s = {0.f, 0.f, 0.f, 0.f};
#pragma unroll
                for (int j = 0; j < 16; ++j) if (j < w) s += ext[15 + t - j];
                const f32x4 z = s * rc - ext[15 + t];
                u32x2 o; o.x = pk2(z.x, z.y); o.y = pk2(z.z, z.w); *(u32x2*)(Zb + (size_t)t * D) = o;
            }
#pragma unroll
            for (int i = 0; i < 15; ++i) *(f32x4*)(po + (size_t)i * D) = ext[8 + i];
        }
    }
}

#define MFMA32(a, b, c) __builtin_amdgcn_mfma_f32_32x32x16_bf16((a), (b), (c), 0, 0, 0)
constexpr int VROW = 192;
constexpr int NT_P = NB * NH * 3 * 64, NT_S = DB * NH * 13, NT_ALL = NT_P + NT_S;
constexpr int KROW = 144;
constexpr int ATT_WL = 32 * KROW + 32 * VROW;
template <int KB0>
__device__ __forceinline__ void attn_task(LAS unsigned char* wl, int lane, const bf16_t* qp, const bf16_t* Kb, const bf16_t* Vb, int pk0, int pkstep, int pkmax, int coloff, float slope_d,
                                          bool qvalid, bf16_t* op, float* lsep) {
    const int rr = lane & 31, hh = lane >> 5;
    const int trq = (lane & 15) >> 2, trp = lane & 3, trblk = (lane >> 4) & 1;
    const int lr = lane >> 3, lc = lane & 7;
    LAS unsigned char* kt = wl; LAS unsigned char* vt_ = wl + 32 * KROW;
    bf16x8 qf[4];
#pragma unroll
    for (int s = 0; s < 4; ++s) qf[s] = *(const bf16x8*)(qp + 16 * s);
    unsigned off[5][4];
#pragma unroll
    for (int kb = KB0; kb < 5; ++kb)
#pragma unroll
        for (int j = 0; j < 4; ++j) { int pk = pk0 + (32 * kb + 8 * j) * pkstep; pk = pk > pkmax ? pkmax : pk; off[kb][j] = (unsigned)(pk * D + coloff); }
    bf16x8 kr[5][4];
#pragma unroll
    for (int kb = KB0; kb < 5; ++kb)
#pragma unroll
        for (int j = 0; j < 4; ++j) kr[kb][j] = *(const bf16x8*)(Kb + off[kb][j]);
    bf16x8 vr[5][4];
#pragma unroll
    for (int kb = KB0; kb < 5; ++kb)
#pragma unroll
        for (int j = 0; j < 4; ++j) vr[kb][j] = *(const bf16x8*)(Vb + off[kb][j]);
    float p[5][16];
    float mx = -3.0e38f;
    const int base = rr + 128 - 4 * hh;
#pragma unroll
    for (int kb = KB0; kb < 5; ++kb) {
#pragma unroll
        for (int j = 0; j < 4; ++j) *(LAS bf16x8*)(kt + (8 * j + lr) * KROW + 16 * lc) = kr[kb][j];
        bf16x8 kf[4];
#pragma unroll
        for (int s = 0; s < 4; ++s) kf[s] = *(const LAS bf16x8*)(kt + rr * KROW + 32 * s + 16 * hh);
        const float tk = -slope_d * (float)(base - 32 * kb);
        f32x16 a;
#pragma unroll
        for (int i = 0; i < 16; ++i) a[i] = __builtin_fmaf(slope_d, (float)((i & 3) + 8 * (i >> 2)), tk);
#pragma unroll
        for (int s = 0; s < 4; ++s) a = MFMA32(kf[s], qf[s], a);
#pragma unroll
        for (int i = 0; i < 16; ++i) {
            float v = a[i];
            if (kb == 0) v = ((i & 3) + 8 * (i >> 2) + 4 * hh >= rr) ? v : -1.0e30f;
            if (kb == 4) v = ((i & 3) + 8 * (i >> 2) + 4 * hh <= rr) ? v : -1.0e30f;
            p[kb][i] = v; mx = fmaxf(mx, v);
        }
    }
    mx = fmaxf(mx, lane_xor(mx, lane, 32));
    float l = 0.f;
    f32x16 o[2];
#pragma unroll
    for (int i = 0; i < 16; ++i) { o[0][i] = 0.f; o[1][i] = 0.f; }
#pragma unroll
    for (int kb = KB0; kb < 5; ++kb) {
#pragma unroll
        for (int i = 0; i < 16; ++i) { const float e = __builtin_amdgcn_exp2f(p[kb][i] - mx); p[kb][i] = e; l += e; }
#pragma unroll
        for (int j = 0; j < 4; ++j) *(LAS bf16x8*)(vt_ + (8 * j + lr) * VROW + 16 * lc) = vr[kb][j];
#pragma unroll
        for (int s2 = 0; s2 < 2; ++s2) {
            u32x4 pw;
            pw.x = pk2(p[kb][8 * s2 + 0], p[kb][8 * s2 + 1]); pw.y = pk2(p[kb][8 * s2 + 2], p[kb][8 * s2 + 3]);
            pw.z = pk2(p[kb][8 * s2 + 4], p[kb][8 * s2 + 5]); pw.w = pk2(p[kb][8 * s2 + 6], p[kb][8 * s2 + 7]);
            const bf16x8 pf = __builtin_bit_cast(bf16x8, pw);
#pragma unroll
            for (int nb = 0; nb < 2; ++nb) {
                const s16x4 lo = __builtin_amdgcn_ds_read_tr16_b64_v4i16((LAS s16x4*)(vt_ + (16 * s2 + 4 * hh + trq) * VROW + 64 * nb + 32 * trblk + 8 * trp));
                const s16x4 hi = __builtin_amdgcn_ds_read_tr16_b64_v4i16((LAS s16x4*)(vt_ + (16 * s2 + 8 + 4 * hh + trq) * VROW + 64 * nb + 32 * trblk + 8 * trp));
                const bf16x8 vt = __builtin_shufflevector(lo, hi, 0, 1, 2, 3, 4, 5, 6, 7);
                o[nb] = MFMA32(vt, pf, o[nb]);
            }
        }
    }
    l += lane_xor(l, lane, 32);
    const float inv = 1.0f / l;
    if (qvalid) {
#pragma unroll
        for (int nb = 0; nb < 2; ++nb)
#pragma unroll
            for (int q4 = 0; q4 < 4; ++q4) { u32x2 w; w.x = pk2(o[nb][4 * q4] * inv, o[nb][4 * q4 + 1] * inv); w.y = pk2(o[nb][4 * q4 + 2] * inv, o[nb][4 * q4 + 3] * inv);
                *(u32x2*)(op + 32 * nb + 8 * q4) = w; }
        if (hh == 0) *lsep = (mx + __builtin_amdgcn_logf(l)) * 0.6931471805599453f;
    }
}
__device__ __forceinline__ void attn_phase(const Ctx& C, int amode, int bx, LAS unsigned char* lds, const bf16_t* Q, const bf16_t* KB, const bf16_t* VB, const bf16_t* KBS, const bf16_t* VBS, bf16_t* OG, float* LSE) {
    LAS unsigned char* wl = lds + C.wave * ATT_WL;
    int lane0 = C.lane;
    const bool xa = (C.G == 256);
    const int xcd = bx & 7, jw = bx >> 3;
    const int nit = xa ? 12 + 4 : (NT_ALL / 8 + C.G - 1) / C.G;
    for (int it = 0; it < nit; ++it) {
        int ch = 0, Tp = -1;
        if (xa) {
            if (it < 12) { const int q = jw + 32 * it, gb = q >> 1, hd = (q & 1) * 8 + C.wave; Tp = ((xcd * 16 + hd) * 3 + gb / 64) * 64 + (gb % 64); }
            else { const int q = jw + 32 * (it - 12); if (q >= 104) break; ch = NT_P / 8 + 104 * xcd + q; }
        } else { ch = bx + it * C.G; if (ch >= NT_ALL / 8) break; }
        const int T = (Tp >= 0) ? Tp : ch * 8 + C.wave;
        if (!((T < NT_P) ? (amode & 1) : (amode & 2))) continue;
        int lane = lane0; asm volatile("" : "+v"(lane));
        const int rr = lane & 31, hh = lane >> 5;
        int b, h, g, r, i0, seqlen, qlo, qhi, mbase; const bf16_t *Kb, *Vb;
        if (T < NT_P) {
            const int blk = T & 63; int x = T >> 6; g = x % 3; x /= 3; h = x & 15; b = x >> 4;
            const int sh_ = 2 * g, nbs = 64 >> sh_; r = blk / nbs; i0 = (blk % nbs) * 32;
            seqlen = SEQ; qlo = 0; qhi = SEQ; mbase = b * SEQ; Kb = KB + (size_t)b * SEQ * D; Vb = VB + (size_t)b * SEQ * D;
        } else {
            int x = T - NT_P; h = x & 15; x >>= 4; const int k = x % 13; b = x / 13;
            if (k == 0) { g = 0; r = 0; i0 = 2048; } else if (k < 5) { g = 1; r = k - 1; i0 = 512; } else { g = 2; r = k - 5; i0 = 128; }
            seqlen = SROWS; qlo = KVB; qhi = SROWS; mbase = MP + b * DT; Kb = KBS + (size_t)b * SROWS * D; Vb = VBS + (size_t)b * SROWS * D;
        }
        const int sh = 2 * g;
        const float slope_d = __builtin_amdgcn_exp2f(-0.5f * (float)(h + 1)) * (float)(1 << sh) * 1.4426950408889634f;
        const int pq = r + ((i0 + rr) << sh);
        const bool qvalid = (pq >= qlo) && (pq < qhi);
        const int pqc = pq < qlo ? qlo : (pq >= qhi ? qhi - 1 : pq);
        const int mrow = mbase + pqc - qlo;
        const bf16_t* qp = Q + (size_t)mrow * NQ + g * D + h * HD + 8 * hh;
        const int pk0 = r + ((i0 - 128 + (lane >> 3)) << sh), pkstep = 1 << sh, coloff = h * HD + 8 * (lane & 7);
        bf16_t* op = OG + ((size_t)g * M + mrow) * D + h * HD + 4 * hh; float* lsep = LSE + ((size_t)g * M + mrow) * NH + h;
        const int kb0 = (i0 < 128) ? ((128 - i0) >> 5) : 0;
        if (kb0 == 0) attn_task<0>(wl, lane, qp, Kb, Vb, pk0, pkstep, seqlen - 1, coloff, slope_d, qvalid, op, lsep);
        else if (kb0 == 1) attn_task<1>(wl, lane, qp, Kb, Vb, pk0, pkstep, seqlen - 1, coloff, slope_d, qvalid, op, lsep);
        else if (kb0 == 2) attn_task<2>(wl, lane, qp, Kb, Vb, pk0, pkstep, seqlen - 1, coloff, slope_d, qvalid, op, lsep);
        else if (kb0 == 3) attn_task<3>(wl, lane, qp, Kb, Vb, pk0, pkstep, seqlen - 1, coloff, slope_d, qvalid, op, lsep);
        else attn_task<4>(wl, lane, qp, Kb, Vb, pk0, pkstep, seqlen - 1, coloff, slope_d, qvalid, op, lsep);
    }
}

__device__ __forceinline__ void combine_pass(const Ctx& C0, const bf16_t* OG, const float* LSE, bf16_t* O) {
    Ctx C = C0; asm volatile("" : "+v"(C.lane));
    const int head = C.lane >> 2;
    constexpr int NR = 4;
    for (int m0 = C.gw; m0 < M; m0 += NR * C.NGW) {
        float l[NR][3]; u32x4 og[NR][3][2]; int mm[NR];
#pragma unroll
        for (int k = 0; k < NR; ++k) { const int m = m0 + k * C.NGW; mm[k] = m < M ? m : m0;
#pragma unroll
            for (int g = 0; g < 3; ++g) { l[k][g] = LSE[((size_t)g * M + mm[k]) * NH + head];
#pragma unroll
                for (int hf = 0; hf < 2; ++hf) og[k][g][hf] = *(const u32x4*)(OG + ((size_t)g * M + mm[k]) * D + 16 * C.lane + 8 * hf); } }
#pragma unroll
        for (int k = 0; k < NR; ++k) {
            if (m0 + k * C.NGW >= M) break;
            const float mx = fmaxf(l[k][0], fmaxf(l[k][1], l[k][2]));
            float w0 = __expf(l[k][0] - mx), w1 = __expf(l[k][1] - mx), w2 = __expf(l[k][2] - mx);
            const float inv = 1.0f / (w0 + w1 + w2); w0 *= inv; w1 *= inv; w2 *= inv;
#pragma unroll
            for (int hf = 0; hf < 2; ++hf) {
                const u32x4 a = og[k][0][hf], b = og[k][1][hf], c = og[k][2][hf];
                u32x4 w;
#pragma unroll
                for (int e = 0; e < 4; ++e) w[e] = pk2(w0 * bf_lo(a[e]) + w1 * bf_lo(b[e]) + w2 * bf_lo(c[e]), w0 * bf_hi(a[e]) + w1 * bf_hi(b[e]) + w2 * bf_hi(c[e]));
                *(u32x4*)(O + (size_t)mm[k] * D + 16 * C.lane + 8 * hf) = w;
            }
        }
    }
}

constexpr int CP_ROWS = KVB - DT, CP_ITEMS = 2 * DB * CP_ROWS;
constexpr int CP_Q_UG = 10176, CP_Q_WQ = 23424, CP_Q_KV = CP_ITEMS - 8 * CP_Q_UG - 2 * CP_Q_WQ;
static_assert(CP_Q_KV >= 0 && CP_Q_KV < 4000, "copy quotas");
__device__ __forceinline__ void copy_rows(int lane_, int nw, int nwaves, int lo, int cnt, const float* cache_k, const float* cache_v, float* out) {
    int lane = lane_; asm volatile("" : "+v"(lane));
    constexpr int NB_ = 4;
    for (int i = nw; i < cnt; i += NB_ * nwaves) {
        const float* src[NB_]; float* dst[NB_]; bool ok[NB_];
#pragma unroll
        for (int k = 0; k < NB_; ++k) { const int ii = i + k * nwaves; ok[k] = ii < cnt; const int idx = lo + (ok[k] ? ii : i);
            const int kv = idx / (DB * CP_ROWS), rem = idx % (DB * CP_ROWS), b = rem / CP_ROWS, jo = rem % CP_ROWS;
            src[k] = (kv ? cache_v : cache_k) + ((size_t)b * KVB + jo + DT) * D + 4 * lane; dst[k] = out + (kv ? O_VS : O_KS) + ((size_t)b * KVB + jo) * D + 4 * lane; }
        f32x4 v[NB_][4];
#pragma unroll
        for (int k = 0; k < NB_; ++k)
#pragma unroll
            for (int q = 0; q < 4; ++q) v[k][q] = __builtin_nontemporal_load((const f32x4*)(src[k] + 256 * q));
#pragma unroll
        for (int k = 0; k < NB_; ++k)
            if (ok[k]) {
#pragma unroll
                for (int q = 0; q < 4; ++q) __builtin_nontemporal_store(v[k][q], (f32x4*)(dst[k] + 256 * q));
            }
    }
}

#define XB_TMO      128
#define XB_XCNT(j)  (256  + 64 * (j))
#define XB_XSUB(j)  (1280 + 64 * (j))
#define XB_XGEN(j)  (2304 + 64 * (j))
#define XB_TOP      3328
#define XB_TOPGEN   3392
#define XCD_BAR_WORDS 3456
#define XB_SPIN_CAP (1u << 20)
__device__ __forceinline__ unsigned xb_ld(unsigned* p)              { return __hip_atomic_load(p, __ATOMIC_RELAXED, __HIP_MEMORY_SCOPE_AGENT); }
__device__ __forceinline__ unsigned xb_add(unsigned* p, unsigned v) { return __hip_atomic_fetch_add(p, v, __ATOMIC_RELAXED, __HIP_MEMORY_SCOPE_AGENT); }
__device__ __forceinline__ unsigned xb_xcc_id() { return (unsigned)__builtin_amdgcn_s_getreg((3 << 11) | 20) & 0xFu; }
#define XB_SPIN(cond, bar) do { unsigned _sp = 0; while (cond) { __builtin_amdgcn_s_sleep(1); \
    if ((++_sp & 255u) == 0u) { if (xb_ld(&(bar)[XB_TMO])) break; if (_sp > XB_SPIN_CAP) { atomicAdd(&(bar)[XB_TMO], 1u); break; } } } } while (0)
struct XcdBarrier { unsigned* bar; unsigned x; volatile LAS unsigned* st; };
__device__ __forceinline__ XcdBarrier xcd_barrier_post(unsigned* bar, volatile LAS unsigned* st) {
    XcdBarrier b; b.bar = bar; b.x = xb_xcc_id(); b.st = st;
    if (threadIdx.x == 0) (void)xb_add(&bar[XB_XCNT(b.x)], 1u);
    return b;
}
__device__ __forceinline__ void xcd_barrier_complete(unsigned* bar, unsigned x, unsigned& nloc, unsigned& nx) {
    const unsigned G = gridDim.x * gridDim.y * gridDim.z;
    unsigned sum, cnt, mine, sp = 0u;
    for (;;) {
        sum = 0u; cnt = 0u; mine = 0u;
#pragma unroll
        for (unsigned j = 0; j < 16; ++j) { const unsigned c = xb_ld(&bar[XB_XCNT(j)]); sum += c; cnt += (c > 0u) ? 1u : 0u; mine = (j == x) ? c : mine; }
        if (sum == G) break;
        __builtin_amdgcn_s_sleep(1);
        if ((++sp & 255u) == 0u) { if (xb_ld(&bar[XB_TMO])) break; if (sp > XB_SPIN_CAP) { atomicAdd(&bar[XB_TMO], 1u); break; } }
    }
    nloc = mine > 0u ? mine : 1u; nx = cnt > 0u ? cnt : 1u;
}
__device__ __forceinline__ void xcd_barrier(const XcdBarrier& b) {
    asm volatile("s_waitcnt vmcnt(0)" ::: "memory");
    __syncthreads();
    if (threadIdx.x == 0) {
        unsigned* bar = b.bar;
        __builtin_amdgcn_s_waitcnt(0);
        unsigned nloc = b.st[0], nx = b.st[1];
        if (nloc == 0u) { xcd_barrier_complete(bar, b.x, nloc, nx); b.st[0] = nloc; b.st[1] = nx; }
        const unsigned old = xb_add(&bar[XB_XSUB(b.x)], 1u);
        const unsigned gen = old / nloc;
        if (old + 1u == (gen + 1u) * nloc) {
            __builtin_amdgcn_fence(__ATOMIC_RELEASE, "agent");
            asm volatile("s_waitcnt vmcnt(0)" ::: "memory");
            const unsigned og = xb_add(&bar[XB_TOP], 1u);
            const unsigned tg = og / nx;
            if (og + 1u == (tg + 1u) * nx) xb_add(&bar[XB_TOPGEN], 1u);
            else XB_SPIN(xb_ld(&bar[XB_TOPGEN]) == tg, bar);
            __builtin_amdgcn_fence(__ATOMIC_ACQUIRE, "agent");
            xb_add(&bar[XB_XGEN(b.x)], 1u);
            asm volatile("s_waitcnt vmcnt(0)" ::: "memory");
        } else {
            XB_SPIN(xb_ld(&bar[XB_XGEN(b.x)]) == gen, bar);
            __builtin_amdgcn_fence(__ATOMIC_ACQUIRE, "agent");
            asm volatile("s_waitcnt vmcnt(0)" ::: "memory");
        }
    }
    __syncthreads();
}

constexpr int SLOTS = 12, NPH = 1 + 4 * SLOTS;
__global__ void __launch_bounds__(NWAVES * 64, 2) yoco_fwd(Args args) {
    extern __shared__ __attribute__((aligned(16))) unsigned char lds_raw[];
    LAS unsigned char* lds = (LAS unsigned char*)lds_raw;
#if MK_ONE_LAUNCH
    cg::grid_group grid = cg::this_grid();
    volatile LAS unsigned* bst = (volatile LAS unsigned*)(lds + 131072 + 256);
    if (threadIdx.x < 2) bst[threadIdx.x] = 0u;
    __syncthreads();
    const XcdBarrier xbar = xcd_barrier_post((unsigned*)args.ws, bst);
#endif
    int again_ = 0;
    for (int ph = args.ph_lo; ph < args.ph_hi; ++ph) {
        bool did = true;
        __attribute__((address_space(1))) unsigned char* wsg_ = (__attribute__((address_space(1))) unsigned char*)args.ws;
        __attribute__((address_space(1))) float* outg_ = (__attribute__((address_space(1))) float*)args.out; int tid_ = threadIdx.x, bx_ = blockIdx.x;
        asm volatile("" : "+s"(wsg_), "+s"(outg_), "+v"(tid_), "+s"(bx_));
        unsigned char* ws = (unsigned char*)wsg_; float* out = (float*)outg_;
        Ctx C; C.lane = tid_ & 63; C.wave = __builtin_amdgcn_readfirstlane(tid_ >> 6); C.G = gridDim.x;
        { const int vcu = (C.G % 8 == 0) ? (bx_ % 8) * (C.G / 8) + bx_ / 8 : bx_; C.gw = vcu * NWAVES + C.wave; C.NGW = C.G * NWAVES; }
        const float *x_p = args.in[0], *x_s = args.in[1], *state = args.in[2], *cache_k = args.in[3], *cache_v = args.in[4], *norm_g = args.in[5];
        const float *w_gate = args.in[6], *w_up = args.in[7], *w_down = args.in[8], *p_win = args.in[9], *p_wgrp = args.in[10], *p_scale = args.in[11], *p_wout = args.in[12];
        const float *kv_norm = args.in[13], *w_k = args.in[14], *w_v = args.in[15], *a_wq = args.in[16], *a_wo = args.in[17];
        bf16_t* H = (bf16_t*)(ws + WS_H);   float* Rs = (float*)(ws + WS_R);   bf16_t* XN = (bf16_t*)(ws + WS_XN); bf16_t* XN2 = (bf16_t*)(ws + WS_XN2); bf16_t* ACT = (bf16_t*)(ws + WS_ACT);
        float* Fb = (float*)(ws + WS_F); float* Pb = (float*)(ws + WS_PART); bf16_t* OG = (bf16_t*)(ws + WS_OG); float* LSE = (float*)(ws + WS_LSE);
        bf16_t *KB = (bf16_t*)(ws + WS_KB), *VB = (bf16_t*)(ws + WS_VB), *KBS = (bf16_t*)(ws + WS_KBS), *VBS = (bf16_t*)(ws + WS_VBS);
        if (ph == 0) for (int rep_ = 0; rep_ < REP_PRO; ++rep_) {
            LAS float* scr = (LAS float*)(lds + C.wave * 16384);
            {
                const TrSrc TS{w_gate, w_up, w_down, p_win, w_k, w_v, a_wo, a_wq, norm_g, kv_norm, ws};
                for (int it = C.gw; it < TR_NITEMS; it += 2 * C.NGW) {
                    const int it1 = it + C.NGW; const bool h1 = it1 < TR_NITEMS;
                    TrJob j0, j1; float va[32], vb[32];
                    tr_decode(TS, it, j0); tr_decode(TS, h1 ? it1 : it, j1);
                    tr_load(j0, C.lane, va); tr_load(j1, C.lane, vb);
                    tr_finish(j0, C.lane, scr, va);
                    if (h1) tr_finish(j1, C.lane, scr, vb);
                }
            }
            for (int it = C.gw; it < 2 * 16 * 128; it += C.NGW) {
                const int kb = it & 127, nbk = (it >> 7) & 15, ly = it >> 11, k0 = kb * 8, g = k0 >> 8, n = nbk * 64 + C.lane;
                const float* G = p_wgrp + ((size_t)(ly * 4 + g) * 256 + (k0 & 255)) * 256;
                const float* S = p_scale + ly * D + g * 256; const float* WO = p_wout + ((size_t)ly * D + g * 256) * D + n;
                float a[8];
#pragma unroll
                for (int q = 0; q < 8; ++q) a[q] = 0.f;
#pragma unroll 2
                for (int j = 0; j < 256; j += 4) {
                    const f32x4 sc4 = *(const f32x4*)(S + j);
                    const float sv0 = sc4.x * WO[(size_t)j * D], sv1 = sc4.y * WO[(size_t)(j + 1) * D], sv2 = sc4.z * WO[(size_t)(j + 2) * D], sv3 = sc4.w * WO[(size_t)(j + 3) * D];
#pragma unroll
                    for (int q = 0; q < 8; ++q) { const f32x4 g4 = *(const f32x4*)(G + q * 256 + j); a[q] += (g4.x * sv0 + g4.y * sv1) + (g4.z * sv2 + g4.w * sv3); }
                }
                u32x4 o; o.x = pk2(a[0], a[1]); o.y = pk2(a[2], a[3]); o.z = pk2(a[4], a[5]); o.w = pk2(a[6], a[7]);
                *(u32x4*)((bf16_t*)(ws + WS_WEFF) + ((size_t)ly * D + n) * D + k0) = o;
            }
            const bool wincopy = (C.G == 256);
            if (wincopy) {
                constexpr int NEED = 1280, NIT = 2 * DB * NEED;
                for (int it0 = C.gw; it0 < NIT; it0 += 4 * C.NGW) {
                    f32x4 v[4][4]; bf16_t* bd[4]; bool ok[4];
#pragma unroll
                    for (int k = 0; k < 4; ++k) { const int itk = it0 + k * C.NGW; ok[k] = itk < NIT; const int it = ok[k] ? itk : it0;
                        const int e = it % NEED, pb = it / NEED, b = pb & 31, kv = pb >> 5, j = (e < 768) ? 16 * (e >> 3) + (e & 7) : e + 768;
                        const float* src = (kv ? cache_v : cache_k) + ((size_t)b * KVB + j) * D + 4 * C.lane; bd[k] = (kv ? VBS : KBS) + ((size_t)b * SROWS + j) * D + 4 * C.lane;
#pragma unroll
                        for (int q = 0; q < 4; ++q) v[k][q] = __builtin_nontemporal_load((const f32x4*)(src + 256 * q)); }
#pragma unroll
                    for (int k = 0; k < 4; ++k)
                        if (ok[k]) {
#pragma unroll
                            for (int q = 0; q < 4; ++q) { u32x2 w; w.x = pk2(v[k][q].x, v[k][q].y); w.y = pk2(v[k][q].z, v[k][q].w); *(u32x2*)(bd[k] + 256 * q) = w; }
                        }
                }
            } else
            for (int it = C.gw; it < 2 * DB * KVB; it += C.NGW) {
                const int j = it & (KVB - 1), b = (it >> 11) & 31, kv = it >> 16;
                const bool need = (j >= 1536) || ((j & 15) < 8);
                if (wincopy && !need) continue;
                const float* src = (kv ? cache_v : cache_k) + ((size_t)b * KVB + j) * D + 4 * C.lane;
                float* dst = out + (kv ? O_VS : O_KS) + ((size_t)b * KVB + (j - DT)) * D + 4 * C.lane;
                bf16_t* bd = (kv ? VBS : KBS) + ((size_t)b * SROWS + j) * D + 4 * C.lane;
#pragma unroll
                for (int q = 0; q < 4; ++q) { const f32x4 v = __builtin_nontemporal_load((const f32x4*)(src + 256 * q));
                    if (!wincopy && j >= DT) __builtin_nontemporal_store(v, (f32x4*)(dst + 256 * q));
                    if (need) { u32x2 w; w.x = pk2(v.x, v.y); w.y = pk2(v.z, v.w); *(u32x2*)(bd + 256 * q) = w; } }
            }
            norm_pass(C, 0, x_p, x_s, nullptr, nullptr, 1, nullptr, 0.f, H, norm_g, XN, nullptr, nullptr, nullptr, Rs);
        } else {
            const int l = (ph - 1) / SLOTS, slot = (ph - 1) % SLOTS;
            const bool pool = l < 2; const int j = l - 2;
            const float* gl = norm_g + (size_t)l * 6 * D;
            int gt = -1; const bf16_t* gA = nullptr; const bf16_t* gB = nullptr; int gN = 0, gK = 0, gS = 1; const float* gR = nullptr;
            const bool fuse = MK_ONE_LAUNCH && (C.G == 256);
            const float* np_gpost = nullptr; const float* np_gnext = nullptr; const float* np_gkv = nullptr; float np_alpha = 0.f; float* np_yout = nullptr; int fp = 0;
            switch (slot) {
                case 0: if (l == 2) { gt = 3; gA = H; gB = (const bf16_t*)(ws + WS_WKV); gN = 2 * D; gK = D; } else did = false; break;
                case 1: case 9: { const int li = l * 2 + (slot == 9); gt = 0; gA = H; gB = (const bf16_t*)(ws + WS_FFN + (size_t)li * FFN_STRIDE); gN = 2 * FF; gK = D; } break;
                case 2: case 10: { const int li = l * 2 + (slot == 10); gt = fuse ? 4 : 1; gA = ACT; gB = (const bf16_t*)(ws + WS_FFN + (size_t)li * FFN_STRIDE + WD_OFF); gN = D; gK = FF; gS = 22;
                    if (slot == 2) { np_gpost = gl + D; np_alpha = 0.5f; np_gnext = gl + 2 * D; fp = l * 3; }
                    else { np_gpost = gl + 5 * D; np_alpha = 0.5f; np_gnext = (l < 3) ? gl + 6 * D : gl; np_gkv = (l == 1) ? kv_norm : nullptr; np_yout = (l == 3) ? out : nullptr; fp = l * 3 + 2; } } break;
                case 3: if (fuse) norm_sample_wg<22>(tid_, C.wave, bx_, (LAS float*)(lds + XL_OFF), Pb, gl + D, 0.5f, H, gl + 2 * D, XN, nullptr, nullptr, nullptr, Rs);
                        else norm_pass(C, 1, nullptr, nullptr, Fb, Pb, 22, gl + D, 0.5f, H, gl + 2 * D, XN, nullptr, nullptr, nullptr, Rs, 0); break;
                case 4: if (pool) { gt = 1; gR = Rs; gA = H; gB = (const bf16_t*)(ws + WS_WIN) + (size_t)l * D * D; gN = D; gK = D; gS = 8; }
                        else { gt = 2; gA = H; gB = (const bf16_t*)(ws + WS_WQ) + (size_t)j * NQ * D; gN = NQ; gK = D; } break;
                case 5: if (pool) pool_pass(C, l, Fb, Pb, 8, state, XN2, out); else for (int rep_ = 0; rep_ < REP_ATTN; ++rep_) attn_phase(C, again_ ? PROBE_AMODE : 3, bx_, lds, ACT, KB, VB, KBS, VBS, OG, LSE); break;
                case 6: if (!pool) combine_pass(C, OG, LSE, XN2); else did = false; break;
                case 7: gt = fuse ? 4 : 1; np_gpost = gl + 3 * D; np_alpha = 1.0f; np_gnext = gl + 4 * D; fp = l * 3 + 1; gA = XN2; gB = pool ? (const bf16_t*)(ws + WS_WEFF) + (size_t)l * D * D : (const bf16_t*)(ws + WS_WO) + (size_t)j * D * D; gN = D; gK = D; gS = 8; break;
                case 8: if (fuse) norm_sample_wg<8>(tid_, C.wave, bx_, (LAS float*)(lds + XL_OFF), Pb, gl + 3 * D, 1.0f, H, gl + 4 * D, XN, nullptr, nullptr, nullptr, Rs);
                        else norm_pass(C, 1, nullptr, nullptr, Fb, Pb, 8, gl + 3 * D, 1.0f, H, gl + 4 * D, XN, nullptr, nullptr, nullptr, Rs, 0); break;
                case 11: if (fuse) norm_sample_wg<22>(tid_, C.wave, bx_, (LAS float*)(lds + XL_OFF), Pb, gl + 5 * D, 0.5f, H, (l < 3) ? gl + 6 * D : gl, XN, (l == 1) ? kv_norm : nullptr, XN2, (l == 3) ? out : nullptr, Rs);
                         else norm_pass(C, 1, nullptr, nullptr, Fb, Pb, 22, gl + 5 * D, 0.5f, H, (l < 3) ? gl + 6 * D : gl, XN, (l == 1) ? kv_norm : nullptr, XN2, (l == 3) ? out : nullptr, Rs, 0); break;
                default: break;
            }
            if (gt >= 0) for (int rep_ = 0; rep_ < REP_GEMM; ++rep_) {
                pg8::Sched S; S.init(gA, gB, gN, gK, gS, C.G, bx_); S.sfirst = (gt == 4) ? 1 : 0;
                if (gt == 0) { pg8::EpiSwiglu E{ACT, Rs}; pg8::gemm_phase(lds, S, E, tid_); }
                else if (gt == 1) { pg8::EpiF32 E{Fb, Pb, gR}; pg8::gemm_phase(lds, S, E, tid_); }
                else if (gt == 2) { pg8::EpiQ E{ACT, 0.125f * 1.4426950408889634f, Rs}; pg8::gemm_phase(lds, S, E, tid_); }
                else if (gt == 4) {
                    unsigned* cntw = (unsigned*)(ws + WS_CNT);
                    PanelEx e1{(unsigned*)(ws + WS_X1), cntw, 32u * (unsigned)(fp + 1)};
                    EpiNorm E{Pb, H, np_gpost, np_alpha, np_gnext, XN, np_gkv, XN2, np_yout, e1, lds + XL_OFF, tid_, Rs}; pg8::gemm_phase(lds, S, E, tid_); }
                else { pg8::EpiKV E{out + O_KP, out + O_VP, out + O_KS, out + O_VS, KB, VB, KBS, VBS, Rs}; pg8::gemm_phase(lds, S, E, tid_); }
                if (C.G == 256 && !again_) {
                    int c0 = -1, lo = 0, cnt = 0;
                    if (slot == 1 || slot == 9) { c0 = 150; cnt = CP_Q_UG; lo = (l * 2 + (slot == 9)) * CP_Q_UG; }
                    else if (slot == 4 && !pool) { c0 = 12; cnt = CP_Q_WQ; lo = 8 * CP_Q_UG + j * CP_Q_WQ; }
                    else if (slot == 0) { c0 = 8; cnt = CP_Q_KV; lo = 8 * CP_Q_UG + 2 * CP_Q_WQ; }
                    if (c0 >= 0 && bx_ >= c0) copy_rows(C.lane, (bx_ - c0) * NWAVES + C.wave, (256 - c0) * NWAVES, lo, cnt, cache_k, cache_v, out);
                }
            }
        }
#if MK_ONE_LAUNCH
        if (did && ph + 1 < args.ph_hi) { if (ph == 0) grid.sync(); else xcd_barrier(xbar); }
        if (PROBE_SLOT >= 0 && ph > 0 && (ph - 1) % SLOTS == PROBE_SLOT && (ph - 1) / SLOTS >= PROBE_LMIN && (ph - 1) / SLOTS <= PROBE_LMAX && !again_) { again_ = 1; --ph; } else again_ = 0;
#endif
    }
}

extern "C" void kernel_launch(void* const* d_in, const int* in_sizes, int n_in, void* d_out, int out_size, void* d_ws, size_t ws_size, hipStream_t stream) {
    static int grid = 0;
    if (grid == 0) {
        if (n_in != 18 || ws_size < WS_END) { fprintf(stderr, "kernel_launch: unexpected inputs (n_in %d, ws %zu < %zu)\n", n_in, ws_size, (size_t)WS_END); grid = -1; return; }
        int dev = 0, cus = 0;
        if (hipGetDevice(&dev) != hipSuccess || hipDeviceGetAttribute(&cus, hipDeviceAttributeMultiprocessorCount, dev) != hipSuccess) { grid = -1; return; }
        if (hipFuncSetAttribute((const void*)yoco_fwd, hipFuncAttributeMaxDynamicSharedMemorySize, LDS_BYTES) != hipSuccess) { fprintf(stderr, "kernel_launch: hipFuncSetAttribute failed\n"); grid = -1; return; }
        int per_cu = 0;
        if (hipOccupancyMaxActiveBlocksPerMultiprocessor(&per_cu, (const void*)yoco_fwd, NWAVES * 64, LDS_BYTES) != hipSuccess || per_cu < 1) { fprintf(stderr, "kernel_launch: occupancy query says %d\n", per_cu); per_cu = 1; }
        (void)hipGetLastError();
        grid = cus;
    }
    if (grid < 0) return;
#if MK_ONE_LAUNCH
    if (hipMemsetAsync(d_ws, 0, 32768, stream) != hipSuccess) { fprintf(stderr, "kernel_launch: memset failed\n"); return; }
#endif
    Args a{};
    for (int i = 0; i < 18; ++i) a.in[i] = (const float*)d_in[i];
    a.out = (float*)d_out; a.ws = (unsigned char*)d_ws;
#if MK_ONE_LAUNCH
    a.ph_lo = 0; a.ph_hi = NPH;
    void* kargs[] = {&a};
    hipError_t e = hipLaunchCooperativeKernel((const void*)yoco_fwd, dim3(grid), dim3(NWAVES * 64), kargs, LDS_BYTES, stream);
    if (e != hipSuccess) fprintf(stderr, "kernel_launch: cooperative launch failed: %s (grid %d)\n", hipGetErrorString(e), grid);
#else
    for (int ph = 0; ph < NPH; ++ph) {
        if (ph > 0) { const int l = (ph - 1) / SLOTS, slot = (ph - 1) % SLOTS; if ((slot == 0 && l != 2) || (slot == 6 && l < 2)) continue; }
        a.ph_lo = ph; a.ph_hi = ph + 1;
        hipLaunchKernelGGL(yoco_fwd, dim3(grid), dim3(NWAVES * 64), LDS_BYTES, stream, a);
    }
#endif
}
```

```cpp
#include <hip/hip_runtime.h>
#include <hip/hip_cooperative_groups.h>
#include <cstdio>
#include <cstdint>
namespace cg = cooperative_groups;

#ifndef REP_GEMM
#define REP_GEMM 1
#endif
#ifndef REP_ATTN
#define REP_ATTN 1
#endif
#ifndef REP_PRO
#define REP_PRO 1
#endif
#ifndef PROBE_SLOT
#define PROBE_SLOT -1
#endif
#ifndef PROBE_LMIN
#define PROBE_LMIN 0
#endif
#ifndef PROBE_LMAX
#define PROBE_LMAX 3
#endif
#ifndef PROBE_AMODE
#define PROBE_AMODE 3
#endif
#ifndef MK_ONE_LAUNCH
#define MK_ONE_LAUNCH 1
#endif

#define LAS __attribute__((address_space(3)))
typedef unsigned short bf16_t;
typedef short bf16x8 __attribute__((ext_vector_type(8)));
typedef short s16x4 __attribute__((ext_vector_type(4)));
typedef float f32x4 __attribute__((ext_vector_type(4)));
typedef float f32x2 __attribute__((ext_vector_type(2)));
typedef float f32x16 __attribute__((ext_vector_type(16)));
typedef unsigned u32x4 __attribute__((ext_vector_type(4)));
typedef unsigned u32x2 __attribute__((ext_vector_type(2)));
typedef __bf16 bf16v2 __attribute__((ext_vector_type(2)));

__device__ __forceinline__ unsigned pk2(float lo, float hi) { f32x2 v = {lo, hi}; bf16v2 r = __builtin_convertvector(v, bf16v2); return __builtin_bit_cast(unsigned, r); }
__device__ __forceinline__ float bf_lo(unsigned w) { return __uint_as_float(w << 16); }
__device__ __forceinline__ float bf_hi(unsigned w) { return __uint_as_float(w & 0xffff0000u); }
__device__ __forceinline__ f32x4 ld_bf4(const bf16_t* p) { const u32x2 w = *(const u32x2*)p; return (f32x4){bf_lo(w.x), bf_hi(w.x), bf_lo(w.y), bf_hi(w.y)}; }
__device__ __forceinline__ void st_bf4(bf16_t* p, const f32x4 v) { u32x2 w; w.x = pk2(v.x, v.y); w.y = pk2(v.z, v.w); *(u32x2*)p = w; }

constexpr int D = 1024, FF = 2816, MP = 16384, MS = 256, M = MP + MS, SEQ = 2048, NB = 8, DB = 32, DT = 8, KVB = 2048, SROWS = KVB + DT;
constexpr int NH = 16, HD = 64, NQ = 3 * D;
constexpr float EPS = 1e-6f;
constexpr size_t O_YP = 0, O_YS = 16777216, O_PP = 17039360, O_KP = 17285120, O_VP = 34062336, O_PS = 50839552, O_KS = 51822592, O_VS = 118931456;
constexpr size_t MiB = 1u << 20;
constexpr size_t WS_FFN = 1 * MiB;
constexpr size_t FFN_STRIDE = 17301504, WD_OFF = 11534336;
constexpr size_t WS_WIN = 133 * MiB, WS_WEFF = 137 * MiB, WS_WKV = 141 * MiB, WS_WQ = 145 * MiB, WS_WO = 157 * MiB;
constexpr size_t WS_H = 161 * MiB;
constexpr size_t WS_XN = 226 * MiB;
constexpr size_t WS_XN2 = WS_XN + 34078720;
constexpr size_t WS_ACT = 291 * MiB;
constexpr size_t WS_F = WS_ACT + 102236160;
constexpr size_t WS_PART = WS_F + 68157440;
constexpr size_t WS_OG = WS_PART + 22 * MiB + MiB / 2;
constexpr size_t WS_LSE = WS_OG + 102236160;
constexpr size_t WS_KB = 577 * MiB, WS_VB = 609 * MiB;
constexpr size_t WS_KBS = 641 * MiB;
constexpr size_t WS_VBS = WS_KBS + 134742016;
constexpr size_t WS_END = WS_VBS + 134742016;
static_assert(WS_LSE + 3 * (size_t)M * 16 * 4 <= WS_KB, "ws map");

constexpr int LDS_BYTES = 147456;
constexpr int NWAVES = 8;

namespace pg8 {
constexpr int BM = 256, BK = 64, HALF = 128, HTB = HALF * BK * 2, STAGE_BYTES = 8 * HTB;
__device__ __forceinline__ int lds_byte(int r, int c) { const int st = (r >> 4) * 2 + (c >> 5), rr = r & 15, cc = c & 31, ob = rr * 64 + cc * 2; return st * 1024 + (ob ^ (((ob >> 9) & 1) << 5)); }
__device__ __forceinline__ void stage_rc(int b, int& R, int& C) { const int st = b / 1024, sb = b % 1024, swz = sb ^ (((sb >> 9) & 1) << 5); R = (st >> 1) * 16 + swz / 64; C = (st & 1) * 32 + (swz % 64) / 2; }
__device__ __forceinline__ int perm32(int rho) { const int n = rho >> 4, i = rho & 15; return 8 * (i >> 2) + 4 * n + (i & 3); }

struct Unit { const char* A; const char* B; int nt, pm, pn, ks; };

struct Sched {
    const char* A; const char* Bt; int ld, nN, nwgP, G, c, nsplit, ntf;
    __device__ __forceinline__ void init(const bf16_t* A_, const bf16_t* Bt_, int N, int K, int nsplit_, int G_, int c_) {
        A = (const char*)A_; Bt = (const char*)Bt_; ld = K; nN = N / BM; nwgP = 64 * nN; G = G_; c = c_; nsplit = nsplit_; ntf = K / BK; }
    int sfirst = 0;
    __device__ __forceinline__ bool next(int i, Unit& u) const {
        long L = (long)i * G + c; const size_t tstep = (size_t)BM * ld * 2;
        if (sfirst) { const bool hasS = c < nN * nsplit; if (i > (hasS ? 1 : 0)) return false; L = (hasS && i == 0) ? (long)nwgP + c : (long)c; }
        if (L < nwgP) {
            int wgid = (int)L; { const int q = nwgP / 8, xcd = wgid % 8, off = wgid / 8; wgid = xcd * q + off; }
            const int nig = 8 * nN, gid = wgid / nig, fm = gid * 8;
            u.pm = fm + ((wgid % nig) % 8); u.pn = (wgid % nig) / 8; u.ks = 0; u.nt = ntf;
            u.A = A + (size_t)u.pm * tstep; u.B = Bt + (size_t)u.pn * tstep; return true;
        }
        L -= nwgP; if (L >= (long)nN * nsplit) return false;
        u.pm = 64; u.pn = (int)(L % nN); u.ks = (int)(L / nN); u.nt = ntf / nsplit;
        const size_t koff = (size_t)u.ks * u.nt * (BK * 2);
        u.A = A + 64 * tstep + koff; u.B = Bt + (size_t)u.pn * tstep + koff; return true;
    }
};

__device__ __forceinline__ float row_scale(const float* R, int row) { const f32x4 q = *(const f32x4*)(R + 4 * (size_t)row); return __builtin_amdgcn_rsqf(((q.x + q.y) + (q.z + q.w)) * (1.0f / 1024.0f) + 1e-6f); }
__device__ __forceinline__ float silu_mul(float g, float u) { return g * u * __builtin_amdgcn_rcpf(1.0f + __expf(-g)); }

struct EpiSwiglu {
    static constexpr bool PERM = true, AFTER_DRAIN = false;
    bf16_t* O; const float* R;
    __device__ __forceinline__ void operator()(const f32x4 (&acc)[2][2][4][2], const Unit& u, int wr, int wc, int fr, int fq) const {
        asm volatile("" : "+v"(fr), "+v"(fq));
        const int col0 = u.pn * HALF + wc * 32 + 8 * fq;
#pragma unroll
        for (int ai = 0; ai < 2; ++ai)
#pragma unroll
            for (int m = 0; m < 4; ++m) {
                const int grow = u.pm * BM + ai * HALF + wr * 64 + m * 16 + fr; const float rs = row_scale(R, grow);
                bf16_t* rowp = O + (size_t)grow * FF + col0;
                const f32x4 g0 = acc[ai][0][m][0] * rs, g1 = acc[ai][0][m][1] * rs, u0 = acc[ai][1][m][0] * rs, u1 = acc[ai][1][m][1] * rs;
                u32x4 w;
                w.x = pk2(silu_mul(g0[0], u0[0]), silu_mul(g0[1], u0[1])); w.y = pk2(silu_mul(g0[2], u0[2]), silu_mul(g0[3], u0[3]));
                w.z = pk2(silu_mul(g1[0], u1[0]), silu_mul(g1[1], u1[1])); w.w = pk2(silu_mul(g1[2], u1[2]), silu_mul(g1[3], u1[3]));
                *(u32x4*)rowp = w;
            }
    }
};
struct EpiQ {
    static constexpr bool PERM = true, AFTER_DRAIN = false;
    bf16_t* O; float scale; const float* R;
    __device__ __forceinline__ void operator()(const f32x4 (&acc)[2][2][4][2], const Unit& u, int wr, int wc, int fr, int fq) const {
        asm volatile("" : "+v"(fr), "+v"(fq));
        const int col0 = u.pn * BM + wc * 32 + 8 * fq;
#pragma unroll
        for (int ai = 0; ai < 2; ++ai)
#pragma unroll
            for (int m = 0; m < 4; ++m) {
                const int grow = u.pm * BM + ai * HALF + wr * 64 + m * 16 + fr; const float rs = scale * row_scale(R, grow);
                bf16_t* rowp = O + (size_t)grow * NQ + col0;
#pragma unroll
                for (int bj = 0; bj < 2; ++bj) { const f32x4 v0 = acc[ai][bj][m][0] * rs, v1 = acc[ai][bj][m][1] * rs;
                    u32x4 w; w.x = pk2(v0[0], v0[1]); w.y = pk2(v0[2], v0[3]); w.z = pk2(v1[0], v1[1]); w.w = pk2(v1[2], v1[3]);
                    *(u32x4*)(rowp + bj * HALF) = w; }
            }
    }
};
struct EpiF32 {
    static constexpr bool PERM = false, AFTER_DRAIN = false;
    float* F; float* P; const float* R;
    __device__ __forceinline__ void operator()(const f32x4 (&acc)[2][2][4][2], const Unit& u, int wr, int wc, int fr, int fq) const {
        asm volatile("" : "+v"(fr), "+v"(fq));
        float* base = (u.pm < 64) ? F + (size_t)u.pm * BM * D : P + (size_t)u.ks * BM * D;
        const int col0 = u.pn * BM + wc * 32 + 4 * fq;
#pragma unroll
        for (int ai = 0; ai < 2; ++ai)
#pragma unroll
            for (int m = 0; m < 4; ++m) {
                const int lrow = ai * HALF + wr * 64 + m * 16 + fr; const float rs = R ? row_scale(R, u.pm * BM + lrow) : 1.0f;
                float* rowp = base + (size_t)lrow * D + col0;
#pragma unroll
                for (int bj = 0; bj < 2; ++bj)
#pragma unroll
                    for (int n = 0; n < 2; ++n) *(f32x4*)(rowp + bj * HALF + n * 16) = acc[ai][bj][m][n] * rs;
                asm volatile("" ::: "memory");
            }
    }
};
struct EpiKV {
    static constexpr bool PERM = false, AFTER_DRAIN = false;
    float *oKp, *oVp, *oKs, *oVs; bf16_t *KB, *VB, *KBS, *VBS; const float* R;
    __device__ __forceinline__ void operator()(const f32x4 (&acc)[2][2][4][2], const Unit& u, int wr, int wc, int fr, int fq) const {
        asm volatile("" : "+v"(fr), "+v"(fq));
        const bool isV = u.pn >= 4; const int col0 = (u.pn & 3) * BM + wc * 32 + 4 * fq;
#pragma unroll
        for (int ai = 0; ai < 2; ++ai)
#pragma unroll
            for (int m = 0; m < 4; ++m) {
                const int lrow = ai * HALF + wr * 64 + m * 16 + fr; float* fo; bf16_t* bo; const float rs = row_scale(R, u.pm * BM + lrow);
                if (u.pm < 64) { const size_t g = (size_t)(u.pm * BM + lrow) * D; fo = (isV ? oVp : oKp) + g; bo = (isV ? VB : KB) + g; }
                else { const int b = lrow >> 3, t = lrow & 7; fo = (isV ? oVs : oKs) + ((size_t)b * KVB + (KVB - DT) + t) * D; bo = (isV ? VBS : KBS) + ((size_t)b * SROWS + KVB + t) * D; }
#pragma unroll
                for (int bj = 0; bj < 2; ++bj)
#pragma unroll
                    for (int n = 0; n < 2; ++n) { const f32x4 v = acc[ai][bj][m][n] * rs; const int c = col0 + bj * HALF + n * 16;
                        *(f32x4*)(fo + c) = v; u32x2 w; w.x = pk2(v[0], v[1]); w.y = pk2(v[2], v[3]); *(u32x2*)(bo + c) = w; }
                asm volatile("" ::: "memory");
            }
    }
};

template <class Epi>
__device__ __forceinline__ void gemm_phase(LAS unsigned char* lds, const Sched& S, const Epi& E, int tid) {
    const int wid = __builtin_amdgcn_readfirstlane(tid >> 6), lane = tid & 63, wr = wid >> 2, wc = wid & 3, fr = lane & 15, fq = lane >> 4;
    const int ld = S.ld;
    unsigned voffA[2], voffB[2];
#pragma unroll
    for (int i = 0; i < 2; ++i) { int R, C; stage_rc(tid * 16 + i * 8192, R, C); const int Rb = Epi::PERM ? ((R & ~31) + perm32(R & 31)) : R;
        voffA[i] = (unsigned)(R * ld + C) * 2u; voffB[i] = (unsigned)(Rb * ld + C) * 2u; }
    const size_t kstep = (size_t)(BK * 2);
    const size_t hstep = (size_t)HALF * ld * 2;
    const unsigned ldsw = (unsigned)wid * 1024u;
    const int aoff = lds_byte(wr * 64 + fr, fq * 8), boff = lds_byte(wc * 32 + fr, fq * 8);
#define PG8_SA(b, h) (((b) * 2 + (h)) * HTB)
#define PG8_SB(b, h) ((4 + (b) * 2 + (h)) * HTB)
#define PG8_STAGE(bufoff, gbase, voff) do { _Pragma("unroll") for (int _i = 0; _i < 2; ++_i) \
        __builtin_amdgcn_global_load_lds((const unsigned*)((const char*)(gbase) + (voff)[_i]), (LAS unsigned*)(lds + (bufoff) + ldsw + _i * 8192), 16, 0, 0); } while (0)
#define PG8_LDA(dst, b, h) do { _Pragma("unroll") for (int m = 0; m < 4; ++m) _Pragma("unroll") for (int k = 0; k < 2; ++k) dst[m][k] = *(const LAS bf16x8*)(lds + PG8_SA(b, h) + aoff + m * 2048 + k * 1024); } while (0)
#define PG8_LDB(dst, b, h) do { _Pragma("unroll") for (int n = 0; n < 2; ++n) _Pragma("unroll") for (int k = 0; k < 2; ++k) dst[n][k] = *(const LAS bf16x8*)(lds + PG8_SB(b, h) + boff + n * 2048 + k * 1024); } while (0)
#define PG8_MMA(ai, bj, At, Bt) do { __builtin_amdgcn_s_setprio(1); _Pragma("unroll") for (int m = 0; m < 4; ++m) _Pragma("unroll") for (int n = 0; n < 2; ++n) _Pragma("unroll") for (int k = 0; k < 2; ++k) \
        acc[ai][bj][m][n] = __builtin_amdgcn_mfma_f32_16x16x32_bf16(Bt[n][k], At[m][k], acc[ai][bj][m][n], 0, 0, 0); __builtin_amdgcn_s_setprio(0); } while (0)
#define PG8_WAIT_V(n) asm volatile("s_waitcnt vmcnt(" #n ")" ::: "memory")
#define PG8_WAIT_L(n) asm volatile("s_waitcnt lgkmcnt(" #n ")" ::: "memory")
#define PG8_BAR __builtin_amdgcn_s_barrier()
#define PG8_SCHED __builtin_amdgcn_sched_barrier(0)
    Unit cur, nxt; int ui = 0;
    if (!S.next(0, cur)) return;
    f32x4 acc[2][2][4][2];
#pragma unroll
    for (int a = 0; a < 2; ++a)
#pragma unroll
        for (int b = 0; b < 2; ++b)
#pragma unroll
            for (int m = 0; m < 4; ++m)
#pragma unroll
                for (int n = 0; n < 2; ++n) acc[a][b][m][n] = (f32x4){0.f, 0.f, 0.f, 0.f};
    bf16x8 At[4][2], B0[2][2], B1[2][2];
    const char* cA = cur.A; const char* cB = cur.B;
    PG8_STAGE(PG8_SB(0, 0), cB, voffB); PG8_STAGE(PG8_SB(0, 1), cB + hstep, voffB); PG8_STAGE(PG8_SA(0, 0), cA, voffA); PG8_STAGE(PG8_SA(0, 1), cA + hstep, voffA);
    if (wr == 1) PG8_BAR;
    PG8_WAIT_V(2); PG8_BAR;
    PG8_STAGE(PG8_SB(1, 0), cB + kstep, voffB); PG8_STAGE(PG8_SA(1, 0), cA + kstep, voffA); PG8_STAGE(PG8_SB(1, 1), cB + hstep + kstep, voffB);
    PG8_WAIT_V(6); PG8_BAR;
    for (;;) {
        const bool has_next = S.next(ui + 1, nxt);
        const char* nA = has_next ? nxt.A : cA; const char* nB = has_next ? nxt.B : cB;
        const int nt = cur.nt;
        for (int t = 0; t < nt; t += 2) {
            const bool last = (t == nt - 2);
            const char* a1 = cA + (size_t)(t + 1) * kstep;
            const char* a2 = last ? nA : cA + (size_t)(t + 2) * kstep; const char* b2 = last ? nB : cB + (size_t)(t + 2) * kstep;
            const char* a3 = a2 + kstep; const char* b3 = b2 + kstep;
            PG8_LDB(B0, 0, 0); PG8_LDB(B1, 0, 1); PG8_SCHED; PG8_LDA(At, 0, 0); PG8_STAGE(PG8_SA(1, 1), a1 + hstep, voffA);
            PG8_WAIT_V(8); PG8_WAIT_L(0); PG8_BAR; PG8_MMA(0, 0, At, B0); PG8_MMA(0, 1, At, B1); PG8_BAR; PG8_SCHED;
            PG8_LDA(At, 0, 1); PG8_STAGE(PG8_SB(0, 0), b2, voffB); PG8_STAGE(PG8_SB(0, 1), b2 + hstep, voffB); PG8_STAGE(PG8_SA(0, 0), a2, voffA);
            PG8_WAIT_V(8); PG8_WAIT_L(0); PG8_BAR; PG8_MMA(1, 0, At, B0); PG8_MMA(1, 1, At, B1); PG8_BAR; PG8_SCHED;
            PG8_LDB(B0, 1, 0); PG8_LDB(B1, 1, 1); PG8_SCHED; PG8_LDA(At, 1, 0); PG8_STAGE(PG8_SA(0, 1), a2 + hstep, voffA);
            PG8_WAIT_V(8); PG8_WAIT_L(0); PG8_BAR; PG8_MMA(0, 0, At, B0); PG8_MMA(0, 1, At, B1); PG8_BAR; PG8_SCHED;
            PG8_LDA(At, 1, 1); PG8_STAGE(PG8_SB(1, 0), b3, voffB); PG8_STAGE(PG8_SB(1, 1), b3 + hstep, voffB); PG8_STAGE(PG8_SA(1, 0), a3, voffA);
            PG8_WAIT_V(8); PG8_WAIT_L(0); PG8_BAR; PG8_MMA(1, 0, At, B0); PG8_MMA(1, 1, At, B1); PG8_BAR; PG8_SCHED;
        }
        if (wr == 0) PG8_BAR;
        if (!Epi::AFTER_DRAIN || has_next) E(acc, cur, wr, wc, fr, fq);
        if (!has_next) break;
#pragma unroll
        for (int a = 0; a < 2; ++a)
#pragma unroll
            for (int b = 0; b < 2; ++b)
#pragma unroll
                for (int m = 0; m < 4; ++m)
#pragma unroll
                    for (int n = 0; n < 2; ++n) acc[a][b][m][n] = (f32x4){0.f, 0.f, 0.f, 0.f};
        cur = nxt; cA = nA; cB = nB; ++ui;
        if (wr == 1) PG8_BAR;
    }
    PG8_WAIT_V(0);
    PG8_BAR;
    if constexpr (Epi::AFTER_DRAIN) E.fused(acc, cur, wr, wc, fr, fq);
#undef PG8_SA
#undef PG8_SB
#undef PG8_STAGE
#undef PG8_LDA
#undef PG8_LDB
#undef PG8_MMA
#undef PG8_WAIT_V
#undef PG8_WAIT_L
#undef PG8_BAR
#undef PG8_SCHED
}
}

struct Args { const float* in[18]; float* out; unsigned char* ws; int ph_lo, ph_hi; };
struct Ctx { int lane, wave, gw, NGW, G; };

__device__ __forceinline__ float lane_xor(float v, int lane, int mask) { return __int_as_float(__builtin_amdgcn_ds_bpermute((lane ^ mask) << 2, __float_as_int(v))); }
__device__ __forceinline__ float wave_sum(float v, int lane) {
#pragma unroll
    for (int o = 1; o < 64; o <<= 1) v += lane_xor(v, lane, o);
    return v;
}
__device__ __forceinline__ float ss4(const f32x4 v) { return (v.x * v.x + v.y * v.y) + (v.z * v.z + v.w * v.w); }

constexpr size_t WS_CNT = 16384, WS_X1 = 65536, WS_X2 = 65536 + 262144, WS_R = 655360;
constexpr int XL_OFF = 131072 + 1024;
struct PanelEx {
    unsigned* xbuf; unsigned* cnt; unsigned want;
    __device__ __forceinline__ void run(const float (&part)[2][4], const pg8::Unit& u, int wr, int wc, int fr, int fq, LAS unsigned char* xl, int wid, int lane) const {
        LAS float* P = (LAS float*)xl; LAS float* S = (LAS float*)(xl + 4096);
#pragma unroll
        for (int ai = 0; ai < 2; ++ai)
#pragma unroll
            for (int m = 0; m < 4; ++m) { float sq = part[ai][m]; sq += lane_xor(sq, lane, 16); sq += lane_xor(sq, lane, 32);
                if (fq == 0) P[(ai * 128 + wr * 64 + m * 16 + fr) * 4 + wc] = sq; }
        asm volatile("s_waitcnt lgkmcnt(0)" ::: "memory"); __builtin_amdgcn_s_barrier(); asm volatile("" ::: "memory");
        const int row = wid * 32 + (lane & 31);
        if (lane < 32) { const float t = (P[row * 4 + 0] + P[row * 4 + 1]) + (P[row * 4 + 2] + P[row * 4 + 3]);
            __hip_atomic_store(xbuf + (size_t)(u.pm * 256 + row) * 4 + u.pn, __float_as_uint(t), __ATOMIC_RELAXED, __HIP_MEMORY_SCOPE_AGENT); }
        asm volatile("s_waitcnt vmcnt(0)" ::: "memory");
        if (lane == 0) __hip_atomic_fetch_add(cnt + 64 * u.pm, 1u, __ATOMIC_RELAXED, __HIP_MEMORY_SCOPE_AGENT);
        if (wid == 0) {
            unsigned sp = 0;
            while ((unsigned)__builtin_amdgcn_readfirstlane(__hip_atomic_load(cnt + 64 * u.pm, __ATOMIC_RELAXED, __HIP_MEMORY_SCOPE_AGENT)) < want) { __builtin_amdgcn_s_sleep(2); if (++sp > (1u << 22)) break; }
            __builtin_amdgcn_fence(__ATOMIC_ACQUIRE, "agent");
        }
        asm volatile("s_waitcnt vmcnt(0) lgkmcnt(0)" ::: "memory"); __builtin_amdgcn_s_barrier(); asm volatile("" ::: "memory");
        if (lane < 32) { const unsigned* sl = xbuf + (size_t)(u.pm * 256 + row) * 4; float t = 0.f;
#pragma unroll
            for (int q = 0; q < 4; ++q) t += __uint_as_float(__hip_atomic_load(sl + q, __ATOMIC_RELAXED, __HIP_MEMORY_SCOPE_AGENT));
            S[row] = t; }
        asm volatile("s_waitcnt lgkmcnt(0)" ::: "memory"); __builtin_amdgcn_s_barrier(); asm volatile("" ::: "memory");
    }
};
struct EpiNorm {
    static constexpr bool PERM = false, AFTER_DRAIN = true;
    float* P; bf16_t* H; const float* gpost; float alpha; const float* gnext; bf16_t* XN; const float* gkv; bf16_t* XN2; float* yout;
    PanelEx e1; LAS unsigned char* xl; int tid; float* R;
    __device__ __forceinline__ void operator()(f32x4 (&acc)[2][2][4][2], const pg8::Unit& u, int wr, int wc, int fr, int fq) const {
        asm volatile("" : "+v"(fr), "+v"(fq));
        const int col0 = u.pn * 256 + wc * 32 + 4 * fq;
        if (u.pm >= 64) {
            float* base = P + (size_t)u.ks * 256 * D;
#pragma unroll
            for (int ai = 0; ai < 2; ++ai)
#pragma unroll
                for (int m = 0; m < 4; ++m) { float* rowp = base + (size_t)(ai * 128 + wr * 64 + m * 16 + fr) * D + col0;
#pragma unroll
                    for (int bj = 0; bj < 2; ++bj)
#pragma unroll
                        for (int n = 0; n < 2; ++n) *(f32x4*)(rowp + bj * 128 + n * 16) = acc[ai][bj][m][n];
                    asm volatile("" ::: "memory"); }
            return;
        }
    }
    __device__ __forceinline__ void fused(f32x4 (&acc)[2][2][4][2], const pg8::Unit& u, int wr, int wc, int fr, int fq) const {
        asm volatile("" : "+v"(fr), "+v"(fq));
        const int col0 = u.pn * 256 + wc * 32 + 4 * fq;
        int lane = tid & 63; asm volatile("" : "+v"(lane));
        const int wid = wr * 4 + wc;
        const LAS float* S = (const LAS float*)(xl + 4096);
        float part[2][4];
#pragma unroll
        for (int ai = 0; ai < 2; ++ai)
#pragma unroll
            for (int m = 0; m < 4; ++m) { float sq = 0.f;
#pragma unroll
                for (int bj = 0; bj < 2; ++bj)
#pragma unroll
                    for (int n = 0; n < 2; ++n) sq += ss4(acc[ai][bj][m][n]);
                part[ai][m] = sq; }
        u32x2 hraw[4][2][2];
#pragma unroll
        for (int m = 0; m < 4; ++m) { const bf16_t* hp = H + (size_t)(u.pm * 256 + wr * 64 + m * 16 + fr) * D + col0;
#pragma unroll
            for (int bj = 0; bj < 2; ++bj)
#pragma unroll
                for (int n = 0; n < 2; ++n) hraw[m][bj][n] = *(const u32x2*)(hp + bj * 128 + n * 16); }
        e1.run(part, u, wr, wc, fr, fq, xl, wid, lane);
        {
            f32x4 g[2][2];
#pragma unroll
            for (int bj = 0; bj < 2; ++bj)
#pragma unroll
                for (int n = 0; n < 2; ++n) g[bj][n] = *(const f32x4*)(gpost + col0 + bj * 128 + n * 16);
#pragma unroll
            for (int ai = 0; ai < 2; ++ai)
#pragma unroll
                for (int m = 0; m < 4; ++m) { const int r = ai * 128 + wr * 64 + m * 16 + fr; const float rf = alpha * __builtin_amdgcn_rsqf(S[r] * (1.0f / D) + EPS);
                    float sq = 0.f;
#pragma unroll
                    for (int bj = 0; bj < 2; ++bj)
#pragma unroll
                        for (int n = 0; n < 2; ++n) { const u32x2 hw = (ai == 0) ? hraw[m][bj][n] : *(const u32x2*)(H + (size_t)(u.pm * 256 + r) * D + col0 + bj * 128 + n * 16); const f32x4 ho = (f32x4){bf_lo(hw.x), bf_hi(hw.x), bf_lo(hw.y), bf_hi(hw.y)}; const f32x4 hn = ho + acc[ai][bj][m][n] * rf * g[bj][n]; acc[ai][bj][m][n] = hn; sq += ss4(hn); }
                    part[ai][m] = sq;
                    asm volatile("" : "+v"(acc[ai][0][m][0]), "+v"(acc[ai][0][m][1]), "+v"(acc[ai][1][m][0]), "+v"(acc[ai][1][m][1]), "+v"(part[ai][m]));
                    if (m & 1) asm volatile("" ::: "memory"); }
        }
        {
            LAS float* P = (LAS float*)xl;
#pragma unroll
            for (int ai = 0; ai < 2; ++ai)
#pragma unroll
                for (int m = 0; m < 4; ++m) { float sq = part[ai][m]; sq += lane_xor(sq, lane, 16); sq += lane_xor(sq, lane, 32);
                    if (fq == 0) P[(ai * 128 + wr * 64 + m * 16 + fr) * 4 + wc] = sq; }
            asm volatile("s_waitcnt lgkmcnt(0)" ::: "memory"); __builtin_amdgcn_s_barrier(); asm volatile("" ::: "memory");
            const int row = wid * 32 + (lane & 31);
            if (lane < 32 && !yout) R[(size_t)(u.pm * 256 + row) * 4 + u.pn] = (P[row * 4 + 0] + P[row * 4 + 1]) + (P[row * 4 + 2] + P[row * 4 + 3]);
        }
        {
#pragma unroll
            for (int ai = 0; ai < 2; ++ai)
#pragma unroll
                for (int m = 0; m < 4; ++m) { const int r = ai * 128 + wr * 64 + m * 16 + fr;
                    const size_t off = (size_t)(u.pm * 256 + r) * D + col0;
#pragma unroll
                    for (int bj = 0; bj < 2; ++bj)
#pragma unroll
                        for (int n = 0; n < 2; ++n) { const f32x4 hn = acc[ai][bj][m][n];
                            if (yout) *(f32x4*)(yout + O_YP + off + bj * 128 + n * 16) = hn; else st_bf4(H + off + bj * 128 + n * 16, hn); }
                    asm volatile("" ::: "memory"); }
        }
    }
};

struct TrJob { const float* W; bf16_t* WT; const float* gain; int K, N, mode, item; };
struct TrSrc { const float *w_gate, *w_up, *w_down, *p_win, *w_k, *w_v, *a_wo, *a_wq, *norm_g, *kv_norm; unsigned char* ws; };
constexpr int TR_I_FFN = 24 * 1408, TR_I_SQ = 6 * 512, TR_I_Q = 2 * 1536, TR_NITEMS = TR_I_FFN + TR_I_SQ + TR_I_Q;
__device__ __forceinline__ void tr_decode(const TrSrc& T, int it, TrJob& j) {
    int r = it;
    if (r < TR_I_FFN) { const int job = r / 1408, li = job / 3, kind = job % 3; j.item = r % 1408;
        bf16_t* dst = (bf16_t*)(T.ws + WS_FFN + (size_t)li * FFN_STRIDE);
        const float* gpre = T.norm_g + (size_t)((li >> 1) * 6 + ((li & 1) ? 4 : 0)) * D;
        if (kind == 0) { j.W = T.w_gate + (size_t)li * D * FF; j.K = D; j.N = FF; j.WT = dst; j.mode = 1; j.gain = gpre; }
        else if (kind == 1) { j.W = T.w_up + (size_t)li * D * FF; j.K = D; j.N = FF; j.WT = dst; j.mode = 2; j.gain = gpre; }
        else { j.W = T.w_down + (size_t)li * D * FF; j.K = FF; j.N = D; j.WT = (bf16_t*)((unsigned char*)dst + WD_OFF); j.mode = 0; j.gain = nullptr; }
        return; }
    r -= TR_I_FFN;
    if (r < TR_I_SQ) { const int job = r / 512; j.item = r % 512; j.K = D; j.N = D; j.mode = 0;
        if (job < 2) { j.W = T.p_win + (size_t)job * D * D; j.WT = (bf16_t*)(T.ws + WS_WIN) + (size_t)job * D * D; j.gain = T.norm_g + (size_t)(job * 6 + 2) * D; }
        else if (job == 2) { j.W = T.w_k; j.WT = (bf16_t*)(T.ws + WS_WKV); j.gain = T.kv_norm; }
        else if (job == 3) { j.W = T.w_v; j.WT = (bf16_t*)(T.ws + WS_WKV) + (size_t)D * D; j.gain = T.kv_norm; }
        else { j.W = T.a_wo + (size_t)(job - 4) * D * D; j.WT = (bf16_t*)(T.ws + WS_WO) + (size_t)(job - 4) * D * D; j.gain = nullptr; }
        return; }
    r -= TR_I_SQ;
    { const int job = r / 1536; j.item = r % 1536; j.K = D; j.N = NQ; j.mode = 0; j.W = T.a_wq + (size_t)job * D * NQ; j.WT = (bf16_t*)(T.ws + WS_WQ) + (size_t)job * NQ * D; j.gain = T.norm_g + (size_t)((2 + job) * 6 + 2) * D; }
}
__device__ __forceinline__ void tr_load(const TrJob& j, int lane, float (&v)[32]) {
    const int nblk = j.N / 32, kb = j.item / nblk, nb = j.item % nblk, k0 = 64 * kb, n0 = 32 * nb;
    const float* p = j.W + (size_t)(k0 + (lane >> 5)) * j.N + n0 + (lane & 31);
#pragma unroll
    for (int i = 0; i < 32; ++i) v[i] = __builtin_nontemporal_load(p + (size_t)(2 * i) * j.N);
}
__device__ __forceinline__ void tr_finish(const TrJob& j, int lane, LAS float* scr, const float (&v)[32]) {
    const int nblk = j.N / 32, kb = j.item / nblk, nb = j.item % nblk, k0 = 64 * kb, n0 = 32 * nb;
#pragma unroll
    for (int i = 0; i < 32; ++i) scr[(2 * i + (lane >> 5)) * 33 + (lane & 31)] = v[i];
    asm volatile("s_waitcnt lgkmcnt(0)" ::: "memory");
    const int orow0 = (j.mode == 0) ? n0 : ((n0 >> 7) * 256 + (n0 & 127) + (j.mode == 2 ? 128 : 0));
    const int c = lane & 7;
    f32x4 ga = {1.f, 1.f, 1.f, 1.f}, gb = {1.f, 1.f, 1.f, 1.f};
    if (j.gain) { ga = *(const f32x4*)(j.gain + k0 + 8 * c); gb = *(const f32x4*)(j.gain + k0 + 8 * c + 4); }
#pragma unroll
    for (int q = 0; q < 4; ++q) { const int n = (lane >> 3) + 8 * q; const LAS float* sp = scr + (8 * c) * 33 + n;
        u32x4 o; o.x = pk2(sp[0 * 33] * ga.x, sp[1 * 33] * ga.y); o.y = pk2(sp[2 * 33] * ga.z, sp[3 * 33] * ga.w); o.z = pk2(sp[4 * 33] * gb.x, sp[5 * 33] * gb.y); o.w = pk2(sp[6 * 33] * gb.z, sp[7 * 33] * gb.w);
        *(u32x4*)(j.WT + (size_t)(orow0 + n) * j.K + k0 + 8 * c) = o; }
    asm volatile("s_waitcnt lgkmcnt(0)" ::: "memory");
}

template <int NR>
__device__ __forceinline__ void norm_rows(int lane, int m0, int stride, int mode, const float* xp, const float* xs, const float* Fb, const float* Pb, int nsplit, const float* gpost, float alpha,
                                          bf16_t* H, const float* gnext, bf16_t* XN, const float* gkv, bf16_t* XN2, float* yout, float* R) {
    f32x4 h[NR][4]; size_t ro[NR];
#pragma unroll
    for (int k = 0; k < NR; ++k) ro[k] = (size_t)(m0 + k * stride) * D + 4 * lane;
    if (mode == 0) {
#pragma unroll
        for (int k = 0; k < NR; ++k) { const int m = m0 + k * stride; const float* src = (m < MP) ? xp + ro[k] : xs + (ro[k] - (size_t)MP * D);
#pragma unroll
            for (int j = 0; j < 4; ++j) h[k][j] = *(const f32x4*)(src + 256 * j); }
    } else {
        f32x4 f[NR][4];
#pragma unroll
        for (int k = 0; k < NR; ++k) { const int m = m0 + k * stride;
            if (m < MP) {
#pragma unroll
                for (int j = 0; j < 4; ++j) f[k][j] = *(const f32x4*)(Fb + ro[k] + 256 * j);
            } else {
                const float* p = Pb + (size_t)(m - MP) * D + 4 * lane;
#pragma unroll
                for (int j = 0; j < 4; ++j) f[k][j] = *(const f32x4*)(p + 256 * j);
                int s = 1;
                for (; s + 3 < nsplit; s += 4) {
                    f32x4 t[4][4];
#pragma unroll
                    for (int q = 0; q < 4; ++q)
#pragma unroll
                        for (int j = 0; j < 4; ++j) t[q][j] = *(const f32x4*)(p + (size_t)(s + q) * MS * D + 256 * j);
#pragma unroll
                    for (int j = 0; j < 4; ++j) f[k][j] += (t[0][j] + t[1][j]) + (t[2][j] + t[3][j]);
                }
                for (; s < nsplit; ++s) {
#pragma unroll
                    for (int j = 0; j < 4; ++j) f[k][j] += *(const f32x4*)(p + (size_t)s * MS * D + 256 * j);
                }
            }
#pragma unroll
            for (int j = 0; j < 4; ++j) h[k][j] = ld_bf4(H + ro[k] + 256 * j);
        }
        f32x4 g[4];
#pragma unroll
        for (int j = 0; j < 4; ++j) g[j] = *(const f32x4*)(gpost + 4 * lane + 256 * j);
#pragma unroll
        for (int k = 0; k < NR; ++k) {
            float ss = 0.f;
#pragma unroll
            for (int j = 0; j < 4; ++j) ss += ss4(f[k][j]);
            const float rf = alpha * __builtin_amdgcn_rsqf(wave_sum(ss, lane) * (1.0f / D) + EPS);
#pragma unroll
            for (int j = 0; j < 4; ++j) h[k][j] += f[k][j] * rf * g[j];
        }
    }
    float sq[NR];
#pragma unroll
    for (int k = 0; k < NR; ++k) {
        float ss = 0.f;
#pragma unroll
        for (int j = 0; j < 4; ++j) ss += ss4(h[k][j]);
        sq[k] = wave_sum(ss, lane);
    }
    if (yout) {
#pragma unroll
        for (int k = 0; k < NR; ++k) { const int m = m0 + k * stride; float* yo = (m < MP) ? yout + O_YP + ro[k] : yout + O_YS + (ro[k] - (size_t)MP * D);
#pragma unroll
            for (int j = 0; j < 4; ++j) *(f32x4*)(yo + 256 * j) = h[k][j]; }
    } else {
#pragma unroll
        for (int k = 0; k < NR; ++k) {
#pragma unroll
            for (int j = 0; j < 4; ++j) st_bf4(H + ro[k] + 256 * j, h[k][j]);
            if (lane == 0) *(f32x4*)(R + 4 * (size_t)(m0 + k * stride)) = (f32x4){sq[k], 0.f, 0.f, 0.f};
        }
    }
}
__device__ __forceinline__ void norm_pass(const Ctx& C0, int mode, const float* xp, const float* xs, const float* Fb, const float* Pb, int nsplit, const float* gpost, float alpha,
                                          bf16_t* H, const float* gnext, bf16_t* XN, const float* gkv, bf16_t* XN2, float* yout, float* R, int m_lo = 0) {
    Ctx C = C0; asm volatile("" : "+v"(C.lane));
    int m = m_lo + C.gw;
    for (; m + 3 * C.NGW < M; m += 4 * C.NGW) norm_rows<4>(C.lane, m, C.NGW, mode, xp, xs, Fb, Pb, nsplit, gpost, alpha, H, gnext, XN, gkv, XN2, yout, R);
    for (; m < M; m += C.NGW) norm_rows<1>(C.lane, m, C.NGW, mode, xp, xs, Fb, Pb, nsplit, gpost, alpha, H, gnext, XN, gkv, XN2, yout, R);
}

template <int NS>
__device__ __forceinline__ void norm_sample_wg(int tid_, int wave, int row, LAS float* red, const float* Pb, const float* gpost, float alpha, bf16_t* H, const float* gnext, bf16_t* XN,
                                               const float* gkv, bf16_t* XN2, float* yout, float* R) {
    int tid = tid_; asm volatile("" : "+v"(tid));
    const int lane = tid & 63, c = 2 * tid;
    const float* p = Pb + (size_t)row * D + c;
    f32x2 pv[NS];
#pragma unroll
    for (int q = 0; q < NS; ++q) pv[q] = *(const f32x2*)(p + (size_t)q * MS * D);
    const size_t ro = (size_t)(MP + row) * D + c;
    const unsigned hw = *(const unsigned*)(H + ro);
    const f32x2 g1 = *(const f32x2*)(gpost + c);
    f32x2 f = pv[0];
#pragma unroll
    for (int q = 1; q < NS; ++q) f += pv[q];
    float ss = wave_sum(f.x * f.x + f.y * f.y, lane);
    if (lane == 0) red[wave] = ss;
    __syncthreads();
    float tot = 0.f;
#pragma unroll
    for (int q = 0; q < 8; ++q) tot += red[q];
    const float rf = alpha * __builtin_amdgcn_rsqf(tot * (1.0f / D) + EPS);
    const f32x2 h = (f32x2){bf_lo(hw), bf_hi(hw)} + f * rf * g1;
    ss = wave_sum(h.x * h.x + h.y * h.y, lane);
    if (lane == 0) red[8 + wave] = ss;
    __syncthreads();
    tot = 0.f;
#pragma unroll
    for (int q = 0; q < 8; ++q) tot += red[8 + q];
    if (yout) { *(f32x2*)(yout + O_YS + (size_t)row * D + c) = h; }
    else { *(unsigned*)(H + ro) = pk2(h.x, h.y); if (tid == 0) *(f32x4*)(R + 4 * (size_t)(MP + row)) = (f32x4){tot, 0.f, 0.f, 0.f}; }
}

__device__ __forceinline__ void pool_pass(const Ctx& C0, int layer, const float* Fb, const float* Pb, int nsplit, const float* state, bf16_t* Z, float* out) {
    Ctx C = C0; asm volatile("" : "+v"(C.lane));
    const int NIT = NB * 64 * 4 + DB * 4;
    for (int it = C.gw; it < NIT; it += C.NGW) {
        if (it < NB * 64 * 4) {
            const int cgp = it & 3, chunk = (it >> 2) & 63, b = it >> 8, w = 2 << cgp, col = cgp * 256 + 4 * C.lane, t0 = chunk * 32;
            const float* U = Fb + (size_t)b * SEQ * D + col; bf16_t* Zb = Z + (size_t)b * SEQ * D + col;
            float* po = out + O_PP + ((size_t)(layer * NB + b) * 15) * D + col;
            f32x4 s = {0.f, 0.f, 0.f, 0.f};
            for (int j = 1; j < w; ++j) { const int t = t0 - j; if (t >= 0) s += *(const f32x4*)(U + (size_t)t * D); }
            for (int tb = t0; tb < t0 + 32; tb += 8) {
                f32x4 ua[8], ub[8];
#pragma unroll
                for (int q = 0; q < 8; ++q) { const int t = tb + q, tp = t - w + 1; ua[q] = *(const f32x4*)(U + (size_t)t * D); ub[q] = *(const f32x4*)(U + (size_t)(tp >= 0 ? tp : 0) * D); }
#pragma unroll
                for (int q = 0; q < 8; ++q) { const int t = tb + q, tp = t - w + 1; const f32x4 ut = ua[q];
                    s += ut;
                    const float rc = 1.0f / (float)((t + 1 < w) ? (t + 1) : w);
                    const f32x4 z = s * rc - ut;
                    u32x2 o; o.x = pk2(z.x, z.y); o.y = pk2(z.z, z.w); *(u32x2*)(Zb + (size_t)t * D) = o;
                    if (tp >= 0) s -= ub[q];
                    if (t >= SEQ - 15) *(f32x4*)(po + (size_t)(t - (SEQ - 15)) * D) = ut; }
            }
        } else {
            const int r = it - NB * 64 * 4, cgp = r & 3, b = r >> 2, w = 2 << cgp, col = cgp * 256 + 4 * C.lane;
            f32x4 ext[23];
            const float* st = state + ((size_t)(layer * DB + b) * 15) * D + col;
#pragma unroll
            for (int e = 0; e < 15; ++e) ext[e] = *(const f32x4*)(st + (size_t)e * D);
#pragma unroll
            for (int t = 0; t < 8; ++t) {
                const float* p = Pb + (size_t)(b * 8 + t) * D + col; f32x4 pa[8];
#pragma unroll
                for (int s = 0; s < 8; ++s) pa[s] = *(const f32x4*)(p + (size_t)s * MS * D);
                ext[15 + t] = ((pa[0] + pa[1]) + (pa[2] + pa[3])) + ((pa[4] + pa[5]) + (pa[6] + pa[7]));
            }
            bf16_t* Zb = Z + ((size_t)MP + b * 8) * D + col; float* po = out + O_PS + ((size_t)(layer * DB + b) * 15) * D + col;
            const float rc = 1.0f / (float)w;
#pragma unroll
            for (int t = 0; t < 8; ++t) {
                f32x4 s = {0.f, 0.f, 0.f, 0.f};
#pragma unroll
                for (int j = 0; j < 16; ++j) if (j < w) s += ext[15 + t - j];
                const f32x4 z = s * rc - ext[15 + t];
                u32x2 o; o.x = pk2(z.x, z.y); o.y = pk2(z.z, z.w); *(u32x2*)(Zb + (size_t)t * D) = o;
            }
#pragma unroll
            for (int i = 0; i < 15; ++i) *(f32x4*)(po + (size_t)i * D) = ext[8 + i];
        }
    }
}

#define MFMA32(a, b, c) __builtin_amdgcn_mfma_f32_32x32x16_bf16((a), (b), (c), 0, 0, 0)
constexpr int VROW = 192;
constexpr int NT_P = NB * NH * 3 * 64, NT_S = DB * NH * 13, NT_ALL = NT_P + NT_S;
constexpr int KROW = 144;
constexpr int ATT_WL = 32 * KROW + 32 * VROW;
template <int KB0>
__device__ __forceinline__ void attn_task(LAS unsigned char* wl, int lane, const bf16_t* qp, const bf16_t* Kb, const bf16_t* Vb, int pk0, int pkstep, int pkmax, int coloff, float slope_d,
                                          bool qvalid, bf16_t* op, float* lsep) {
    const int rr = lane & 31, hh = lane >> 5;
    const int trq = (lane & 15) >> 2, trp = lane & 3, trblk = (lane >> 4) & 1;
    const int lr = lane >> 3, lc = lane & 7;
    LAS unsigned char* kt = wl; LAS unsigned char* vt_ = wl + 32 * KROW;
    bf16x8 qf[4];
#pragma unroll
    for (int s = 0; s < 4; ++s) qf[s] = *(const bf16x8*)(qp + 16 * s);
    unsigned off[5][4];
#pragma unroll
    for (int kb = KB0; kb < 5; ++kb)
#pragma unroll
        for (int j = 0; j < 4; ++j) { int pk = pk0 + (32 * kb + 8 * j) * pkstep; pk = pk > pkmax ? pkmax : pk; off[kb][j] = (unsigned)(pk * D + coloff); }
    bf16x8 kr[5][4];
#pragma unroll
    for (int kb = KB0; kb < 5; ++kb)
#pragma unroll
        for (int j = 0; j < 4; ++j) kr[kb][j] = *(const bf16x8*)(Kb + off[kb][j]);
    bf16x8 vr[5][4];
#pragma unroll
    for (int kb = KB0; kb < 5; ++kb)
#pragma unroll
        for (int j = 0; j < 4; ++j) vr[kb][j] = *(const bf16x8*)(Vb + off[kb][j]);
    float p[5][16];
    float mx = -3.0e38f;
    const int base = rr + 128 - 4 * hh;
#pragma unroll
    for (int kb = KB0; kb < 5; ++kb) {
#pragma unroll
        for (int j = 0; j < 4; ++j) *(LAS bf16x8*)(kt + (8 * j + lr) * KROW + 16 * lc) = kr[kb][j];
        bf16x8 kf[4];
#pragma unroll
        for (int s = 0; s < 4; ++s) kf[s] = *(const LAS bf16x8*)(kt + rr * KROW + 32 * s + 16 * hh);
        const float tk = -slope_d * (float)(base - 32 * kb);
        f32x16 a;
#pragma unroll
        for (int i = 0; i < 16; ++i) a[i] = __builtin_fmaf(slope_d, (float)((i & 3) + 8 * (i >> 2)), tk);
#pragma unroll
        for (int s = 0; s < 4; ++s) a = MFMA32(kf[s], qf[s], a);
#pragma unroll
        for (int i = 0; i < 16; ++i) {
            float v = a[i];
            if (kb == 0) v = ((i & 3) + 8 * (i >> 2) + 4 * hh >= rr) ? v : -1.0e30f;
            if (kb == 4) v = ((i & 3) + 8 * (i >> 2) + 4 * hh <= rr) ? v : -1.0e30f;
            p[kb][i] = v; mx = fmaxf(mx, v);
        }
    }
    mx = fmaxf(mx, lane_xor(mx, lane, 32));
    float l = 0.f;
    f32x16 o[2];
#pragma unroll
    for (int i = 0; i < 16; ++i) { o[0][i] = 0.f; o[1][i] = 0.f; }
#pragma unroll
    for (int kb = KB0; kb < 5; ++kb) {
#pragma unroll
        for (int i = 0; i < 16; ++i) { const float e = __builtin_amdgcn_exp2f(p[kb][i] - mx); p[kb][i] = e; l += e; }
#pragma unroll
        for (int j = 0; j < 4; ++j) *(LAS bf16x8*)(vt_ + (8 * j + lr) * VROW + 16 * lc) = vr[kb][j];
#pragma unroll
        for (int s2 = 0; s2 < 2; ++s2) {
            u32x4 pw;
            pw.x = pk2(p[kb][8 * s2 + 0], p[kb][8 * s2 + 1]); pw.y = pk2(p[kb][8 * s2 + 2], p[kb][8 * s2 + 3]);
            pw.z = pk2(p[kb][8 * s2 + 4], p[kb][8 * s2 + 5]); pw.w = pk2(p[kb][8 * s2 + 6], p[kb][8 * s2 + 7]);
            const bf16x8 pf = __builtin_bit_cast(bf16x8, pw);
#pragma unroll
            for (int nb = 0; nb < 2; ++nb) {
                const s16x4 lo = __builtin_amdgcn_ds_read_tr16_b64_v4i16((LAS s16x4*)(vt_ + (16 * s2 + 4 * hh + trq) * VROW + 64 * nb + 32 * trblk + 8 * trp));
                const s16x4 hi = __builtin_amdgcn_ds_read_tr16_b64_v4i16((LAS s16x4*)(vt_ + (16 * s2 + 8 + 4 * hh + trq) * VROW + 64 * nb + 32 * trblk + 8 * trp));
                const bf16x8 vt = __builtin_shufflevector(lo, hi, 0, 1, 2, 3, 4, 5, 6, 7);
                o[nb] = MFMA32(vt, pf, o[nb]);
            }
        }
    }
    l += lane_xor(l, lane, 32);
    const float inv = 1.0f / l;
    if (qvalid) {
#pragma unroll
        for (int nb = 0; nb < 2; ++nb)
#pragma unroll
            for (int q4 = 0; q4 < 4; ++q4) { u32x2 w; w.x = pk2(o[nb][4 * q4] * inv, o[nb][4 * q4 + 1] * inv); w.y = pk2(o[nb][4 * q4 + 2] * inv, o[nb][4 * q4 + 3] * inv);
                *(u32x2*)(op + 32 * nb + 8 * q4) = w; }
        if (hh == 0) *lsep = (mx + __builtin_amdgcn_logf(l)) * 0.6931471805599453f;
    }
}
__device__ __forceinline__ void attn_phase(const Ctx& C, int amode, int bx, LAS unsigned char* lds, const bf16_t* Q, const bf16_t* KB, const bf16_t* VB, const bf16_t* KBS, const bf16_t* VBS, bf16_t* OG, float* LSE) {
    LAS unsigned char* wl = lds + C.wave * ATT_WL;
    int lane0 = C.lane;
    const bool xa = (C.G == 256);
    const int xcd = bx & 7, jw = bx >> 3;
    const int nit = xa ? 12 + 4 : (NT_ALL / 8 + C.G - 1) / C.G;
    for (int it = 0; it < nit; ++it) {
        int ch = 0, Tp = -1;
        if (xa) {
            if (it < 12) { const int q = jw + 32 * it, gb = q >> 1, hd = (q & 1) * 8 + C.wave; Tp = ((xcd * 16 + hd) * 3 + gb / 64) * 64 + (gb % 64); }
            else { const int q = jw + 32 * (it - 12); if (q >= 104) break; ch = NT_P / 8 + 104 * xcd + q; }
        } else { ch = bx + it * C.G; if (ch >= NT_ALL / 8) break; }
        const int T = (Tp >= 0) ? Tp : ch * 8 + C.wave;
        if (!((T < NT_P) ? (amode & 1) : (amode & 2))) continue;
        int lane = lane0; asm volatile("" : "+v"(lane));
        const int rr = lane & 31, hh = lane >> 5;
        int b, h, g, r, i0, seqlen, qlo, qhi, mbase; const bf16_t *Kb, *Vb;
        if (T < NT_P) {
            const int blk = T & 63; int x = T >> 6; g = x % 3; x /= 3; h = x & 15; b = x >> 4;
            const int sh_ = 2 * g, nbs = 64 >> sh_; r = blk / nbs; i0 = (blk % nbs) * 32;
            seqlen = SEQ; qlo = 0; qhi = SEQ; mbase = b * SEQ; Kb = KB + (size_t)b * SEQ * D; Vb = VB + (size_t)b * SEQ * D;
        } else {
            int x = T - NT_P; h = x & 15; x >>= 4; const int k = x % 13; b = x / 13;
            if (k == 0) { g = 0; r = 0; i0 = 2048; } else if (k < 5) { g = 1; r = k - 1; i0 = 512; } else { g = 2; r = k - 5; i0 = 128; }
            seqlen = SROWS; qlo = KVB; qhi = SROWS; mbase = MP + b * DT; Kb = KBS + (size_t)b * SROWS * D; Vb = VBS + (size_t)b * SROWS * D;
        }
        const int sh = 2 * g;
        const float slope_d = __builtin_amdgcn_exp2f(-0.5f * (float)(h + 1)) * (float)(1 << sh) * 1.4426950408889634f;
        const int pq = r + ((i0 + rr) << sh);
        const bool qvalid = (pq >= qlo) && (pq < qhi);
        const int pqc = pq < qlo ? qlo : (pq >= qhi ? qhi - 1 : pq);
        const int mrow = mbase + pqc - qlo;
        const bf16_t* qp = Q + (size_t)mrow * NQ + g * D + h * HD + 8 * hh;
        const int pk0 = r + ((i0 - 128 + (lane >> 3)) << sh), pkstep = 1 << sh, coloff = h * HD + 8 * (lane & 7);
        bf16_t* op = OG + ((size_t)g * M + mrow) * D + h * HD + 4 * hh; float* lsep = LSE + ((size_t)g * M + mrow) * NH + h;
        const int kb0 = (i0 < 128) ? ((128 - i0) >> 5) : 0;
        if (kb0 == 0) attn_task<0>(wl, lane, qp, Kb, Vb, pk0, pkstep, seqlen - 1, coloff, slope_d, qvalid, op, lsep);
        else if (kb0 == 1) attn_task<1>(wl, lane, qp, Kb, Vb, pk0, pkstep, seqlen - 1, coloff, slope_d, qvalid, op, lsep);
        else if (kb0 == 2) attn_task<2>(wl, lane, qp, Kb, Vb, pk0, pkstep, seqlen - 1, coloff, slope_d, qvalid, op, lsep);
        else if (kb0 == 3) attn_task<3>(wl, lane, qp, Kb, Vb, pk0, pkstep, seqlen - 1, coloff, slope_d, qvalid, op, lsep);
        else attn_task<4>(wl, lane, qp, Kb, Vb, pk0, pkstep, seqlen - 1, coloff, slope_d, qvalid, op, lsep);
    }
}

__device__ __forceinline__ void combine_pass(const Ctx& C0, const bf16_t* OG, const float* LSE, bf16_t* O) {
    Ctx C = C0; asm volatile("" : "+v"(C.lane));
    const int head = C.lane >> 2;
    constexpr int NR = 4;
    for (int m0 = C.gw; m0 < M; m0 += NR * C.NGW) {
        float l[NR][3]; u32x4 og[NR][3][2]; int mm[NR];
#pragma unroll
        for (int k = 0; k < NR; ++k) { const int m = m0 + k * C.NGW; mm[k] = m < M ? m : m0;
#pragma unroll
            for (int g = 0; g < 3; ++g) { l[k][g] = LSE[((size_t)g * M + mm[k]) * NH + head];
#pragma unroll
                for (int hf = 0; hf < 2; ++hf) og[k][g][hf] = *(const u32x4*)(OG + ((size_t)g * M + mm[k]) * D + 16 * C.lane + 8 * hf); } }
#pragma unroll
        for (int k = 0; k < NR; ++k) {
            if (m0 + k * C.NGW >= M) break;
            const float mx = fmaxf(l[k][0], fmaxf(l[k][1], l[k][2]));
            float w0 = __expf(l[k][0] - mx), w1 = __expf(l[k][1] - mx), w2 = __expf(l[k][2] - mx);
            const float inv = 1.0f / (w0 + w1 + w2); w0 *= inv; w1 *= inv; w2 *= inv;
#pragma unroll
            for (int hf = 0; hf < 2; ++hf) {
                const u32x4 a = og[k][0][hf], b = og[k][1][hf], c = og[k][2][hf];
                u32x4 w;
#pragma unroll
                for (int e = 0; e < 4; ++e) w[e] = pk2(w0 * bf_lo(a[e]) + w1 * bf_lo(b[e]) + w2 * bf_lo(c[e]), w0 * bf_hi(a[e]) + w1 * bf_hi(b[e]) + w2 * bf_hi(c[e]));
                *(u32x4*)(O + (size_t)mm[k] * D + 16 * C.lane + 8 * hf) = w;
            }
        }
    }
}

constexpr int CP_ROWS = KVB - DT, CP_ITEMS = 2 * DB * CP_ROWS;
constexpr int CP_Q_UG = 10176, CP_Q_WQ = 23424, CP_Q_KV = CP_ITEMS - 8 * CP_Q_UG - 2 * CP_Q_WQ;
static_assert(CP_Q_KV >= 0 && CP_Q_KV < 4000, "copy quotas");
__device__ __forceinline__ void copy_rows(int lane_, int nw, int nwaves, int lo, int cnt, const float* cache_k, const float* cache_v, float* out) {
    int lane = lane_; asm volatile("" : "+v"(lane));
    constexpr int NB_ = 4;
    for (int i = nw; i < cnt; i += NB_ * nwaves) {
        const float* src[NB_]; float* dst[NB_]; bool ok[NB_];
#pragma unroll
        for (int k = 0; k < NB_; ++k) { const int ii = i + k * nwaves; ok[k] = ii < cnt; const int idx = lo + (ok[k] ? ii : i);
            const int kv = idx / (DB * CP_ROWS), rem = idx % (DB * CP_ROWS), b = rem / CP_ROWS, jo = rem % CP_ROWS;
            src[k] = (kv ? cache_v : cache_k) + ((size_t)b * KVB + jo + DT) * D + 4 * lane; dst[k] = out + (kv ? O_VS : O_KS) + ((size_t)b * KVB + jo) * D + 4 * lane; }
        f32x4 v[NB_][4];
#pragma unroll
        for (int k = 0; k < NB_; ++k)
#pragma unroll
            for (int q = 0; q < 4; ++q) v[k][q] = __builtin_nontemporal_load((const f32x4*)(src[k] + 256 * q));
#pragma unroll
        for (int k = 0; k < NB_; ++k)
            if (ok[k]) {
#pragma unroll
                for (int q = 0; q < 4; ++q) __builtin_nontemporal_store(v[k][q], (f32x4*)(dst[k] + 256 * q));
            }
    }
}

#define XB_TMO      128
#define XB_XCNT(j)  (256  + 64 * (j))
#define XB_XSUB(j)  (1280 + 64 * (j))
#define XB_XGEN(j)  (2304 + 64 * (j))
#define XB_TOP      3328
#define XB_TOPGEN   3392
#define XCD_BAR_WORDS 3456
#define XB_SPIN_CAP (1u << 20)
__device__ __forceinline__ unsigned xb_ld(unsigned* p)              { return __hip_atomic_load(p, __ATOMIC_RELAXED, __HIP_MEMORY_SCOPE_AGENT); }
__device__ __forceinline__ unsigned xb_add(unsigned* p, unsigned v) { return __hip_atomic_fetch_add(p, v, __ATOMIC_RELAXED, __HIP_MEMORY_SCOPE_AGENT); }
__device__ __forceinline__ unsigned xb_xcc_id() { return (unsigned)__builtin_amdgcn_s_getreg((3 << 11) | 20) & 0xFu; }
#define XB_SPIN(cond, bar) do { unsigned _sp = 0; while (cond) { __builtin_amdgcn_s_sleep(1); \
    if ((++_sp & 255u) == 0u) { if (xb_ld(&(bar)[XB_TMO])) break; if (_sp > XB_SPIN_CAP) { atomicAdd(&(bar)[XB_TMO], 1u); break; } } } } while (0)
struct XcdBarrier { unsigned* bar; unsigned x; volatile LAS unsigned* st; };
__device__ __forceinline__ XcdBarrier xcd_barrier_post(unsigned* bar, volatile LAS unsigned* st) {
    XcdBarrier b; b.bar = bar; b.x = xb_xcc_id(); b.st = st;
    if (threadIdx.x == 0) (void)xb_add(&bar[XB_XCNT(b.x)], 1u);
    return b;
}
__device__ __forceinline__ void xcd_barrier_complete(unsigned* bar, unsigned x, unsigned& nloc, unsigned& nx) {
    const unsigned G = gridDim.x * gridDim.y * gridDim.z;
    unsigned sum, cnt, mine, sp = 0u;
    for (;;) {
        sum = 0u; cnt = 0u; mine = 0u;
#pragma unroll
        for (unsigned j = 0; j < 16; ++j) { const unsigned c = xb_ld(&bar[XB_XCNT(j)]); sum += c; cnt += (c > 0u) ? 1u : 0u; mine = (j == x) ? c : mine; }
        if (sum == G) break;
        __builtin_amdgcn_s_sleep(1);
        if ((++sp & 255u) == 0u) { if (xb_ld(&bar[XB_TMO])) break; if (sp > XB_SPIN_CAP) { atomicAdd(&bar[XB_TMO], 1u); break; } }
    }
    nloc = mine > 0u ? mine : 1u; nx = cnt > 0u ? cnt : 1u;
}
__device__ __forceinline__ void xcd_barrier(const XcdBarrier& b) {
    asm volatile("s_waitcnt vmcnt(0)" ::: "memory");
    __syncthreads();
    if (threadIdx.x == 0) {
        unsigned* bar = b.bar;
        __builtin_amdgcn_s_waitcnt(0);
        unsigned nloc = b.st[0], nx = b.st[1];
        if (nloc == 0u) { xcd_barrier_complete(bar, b.x, nloc, nx); b.st[0] = nloc; b.st[1] = nx; }
        const unsigned old = xb_add(&bar[XB_XSUB(b.x)], 1u);
        const unsigned gen = old / nloc;
        if (old + 1u == (gen + 1u) * nloc) {
            __builtin_amdgcn_fence(__ATOMIC_RELEASE, "agent");
            asm volatile("s_waitcnt vmcnt(0)" ::: "memory");
            const unsigned og = xb_add(&bar[XB_TOP], 1u);
            const unsigned tg = og / nx;
            if (og + 1u == (tg + 1u) * nx) xb_add(&bar[XB_TOPGEN], 1u);
            else XB_SPIN(xb_ld(&bar[XB_TOPGEN]) == tg, bar);
            __builtin_amdgcn_fence(__ATOMIC_ACQUIRE, "agent");
            xb_add(&bar[XB_XGEN(b.x)], 1u);
            asm volatile("s_waitcnt vmcnt(0)" ::: "memory");
        } else {
            XB_SPIN(xb_ld(&bar[XB_XGEN(b.x)]) == gen, bar);
            __builtin_amdgcn_fence(__ATOMIC_ACQUIRE, "agent");
            asm volatile("s_waitcnt vmcnt(0)" ::: "memory");
        }
    }
    __syncthreads();
}

constexpr int SLOTS = 12, NPH = 1 + 4 * SLOTS;
__global__ void __launch_bounds__(NWAVES * 64, 2) yoco_fwd(Args args) {
    extern __shared__ __attribute__((aligned(16))) unsigned char lds_raw[];
    LAS unsigned char* lds = (LAS unsigned char*)lds_raw;
#if MK_ONE_LAUNCH
    cg::grid_group grid = cg::this_grid();
    volatile LAS unsigned* bst = (volatile LAS unsigned*)(lds + 131072 + 256);
    if (threadIdx.x < 2) bst[threadIdx.x] = 0u;
    __syncthreads();
    XcdBarrier xbar; xbar.bar = (unsigned*)args.ws; xbar.x = xb_xcc_id(); xbar.st = bst;
    if (blockIdx.x == 0) {
        for (int w = threadIdx.x; w < 8192; w += NWAVES * 64) __hip_atomic_store((unsigned*)args.ws + w, 0u, __ATOMIC_RELAXED, __HIP_MEMORY_SCOPE_AGENT);
    }
#endif
    int again_ = 0;
    for (int ph = args.ph_lo; ph < args.ph_hi; ++ph) {
        bool did = true;
        __attribute__((address_space(1))) unsigned char* wsg_ = (__attribute__((address_space(1))) unsigned char*)args.ws;
        __attribute__((address_space(1))) float* outg_ = (__attribute__((address_space(1))) float*)args.out; int tid_ = threadIdx.x, bx_ = blockIdx.x;
        asm volatile("" : "+s"(wsg_), "+s"(outg_), "+v"(tid_), "+s"(bx_));
        unsigned char* ws = (unsigned char*)wsg_; float* out = (float*)outg_;
        Ctx C; C.lane = tid_ & 63; C.wave = __builtin_amdgcn_readfirstlane(tid_ >> 6); C.G = gridDim.x;
        { const int vcu = (C.G % 8 == 0) ? (bx_ % 8) * (C.G / 8) + bx_ / 8 : bx_; C.gw = vcu * NWAVES + C.wave; C.NGW = C.G * NWAVES; }
        const float *x_p = args.in[0], *x_s = args.in[1], *state = args.in[2], *cache_k = args.in[3], *cache_v = args.in[4], *norm_g = args.in[5];
        const float *w_gate = args.in[6], *w_up = args.in[7], *w_down = args.in[8], *p_win = args.in[9], *p_wgrp = args.in[10], *p_scale = args.in[11], *p_wout = args.in[12];
        const float *kv_norm = args.in[13], *w_k = args.in[14], *w_v = args.in[15], *a_wq = args.in[16], *a_wo = args.in[17];
        bf16_t* H = (bf16_t*)(ws + WS_H);   float* Rs = (float*)(ws + WS_R);   bf16_t* XN = (bf16_t*)(ws + WS_XN); bf16_t* XN2 = (bf16_t*)(ws + WS_XN2); bf16_t* ACT = (bf16_t*)(ws + WS_ACT);
        float* Fb = (float*)(ws + WS_F); float* Pb = (float*)(ws + WS_PART); bf16_t* OG = (bf16_t*)(ws + WS_OG); float* LSE = (float*)(ws + WS_LSE);
        bf16_t *KB = (bf16_t*)(ws + WS_KB), *VB = (bf16_t*)(ws + WS_VB), *KBS = (bf16_t*)(ws + WS_KBS), *VBS = (bf16_t*)(ws + WS_VBS);
        if (ph == 0) for (int rep_ = 0; rep_ < REP_PRO; ++rep_) {
            LAS float* scr = (LAS float*)(lds + C.wave * 16384);
            {
                const TrSrc TS{w_gate, w_up, w_down, p_win, w_k, w_v, a_wo, a_wq, norm_g, kv_norm, ws};
                for (int it = C.gw; it < TR_NITEMS; it += 2 * C.NGW) {
                    const int it1 = it + C.NGW; const bool h1 = it1 < TR_NITEMS;
                    TrJob j0, j1; float va[32], vb[32];
                    tr_decode(TS, it, j0); tr_decode(TS, h1 ? it1 : it, j1);
                    tr_load(j0, C.lane, va); tr_load(j1, C.lane, vb);
                    tr_finish(j0, C.lane, scr, va);
                    if (h1) tr_finish(j1, C.lane, scr, vb);
                }
            }
            for (int it = C.gw; it < 2 * 16 * 128; it += C.NGW) {
                const int kb = it & 127, nbk = (it >> 7) & 15, ly = it >> 11, k0 = kb * 8, g = k0 >> 8, n = nbk * 64 + C.lane;
                const float* G = p_wgrp + ((size_t)(ly * 4 + g) * 256 + (k0 & 255)) * 256;
                const float* S = p_scale + ly * D + g * 256; const float* WO = p_wout + ((size_t)ly * D + g * 256) * D + n;
                float a[8];
#pragma unroll
                for (int q = 0; q < 8; ++q) a[q] = 0.f;
#pragma unroll 2
                for (int j = 0; j < 256; j += 4) {
                    const f32x4 sc4 = *(const f32x4*)(S + j);
                    const float sv0 = sc4.x * WO[(size_t)j * D], sv1 = sc4.y * WO[(size_t)(j + 1) * D], sv2 = sc4.z * WO[(size_t)(j + 2) * D], sv3 = sc4.w * WO[(size_t)(j + 3) * D];
#pragma unroll
                    for (int q = 0; q < 8; ++q) { const f32x4 g4 = *(const f32x4*)(G + q * 256 + j); a[q] += (g4.x * sv0 + g4.y * sv1) + (g4.z * sv2 + g4.w * sv3); }
                }
                u32x4 o; o.x = pk2(a[0], a[1]); o.y = pk2(a[2], a[3]); o.z = pk2(a[4], a[5]); o.w = pk2(a[6], a[7]);
                *(u32x4*)((bf16_t*)(ws + WS_WEFF) + ((size_t)ly * D + n) * D + k0) = o;
            }
            const bool wincopy = (C.G == 256);
            if (wincopy) {
                constexpr int NEED = 1280, NIT = 2 * DB * NEED;
                for (int it0 = C.gw; it0 < NIT; it0 += 4 * C.NGW) {
                    f32x4 v[4][4]; bf16_t* bd[4]; bool ok[4];
#pragma unroll
                    for (int k = 0; k < 4; ++k) { const int itk = it0 + k * C.NGW; ok[k] = itk < NIT; const int it = ok[k] ? itk : it0;
                        const int e = it % NEED, pb = it / NEED, b = pb & 31, kv = pb >> 5, j = (e < 768) ? 16 * (e >> 3) + (e & 7) : e + 768;
                        const float* src = (kv ? cache_v : cache_k) + ((size_t)b * KVB + j) * D + 4 * C.lane; bd[k] = (kv ? VBS : KBS) + ((size_t)b * SROWS + j) * D + 4 * C.lane;
#pragma unroll
                        for (int q = 0; q < 4; ++q) v[k][q] = __builtin_nontemporal_load((const f32x4*)(src + 256 * q)); }
#pragma unroll
                    for (int k = 0; k < 4; ++k)
                        if (ok[k]) {
#pragma unroll
                            for (int q = 0; q < 4; ++q) { u32x2 w; w.x = pk2(v[k][q].x, v[k][q].y); w.y = pk2(v[k][q].z, v[k][q].w); *(u32x2*)(bd[k] + 256 * q) = w; }
                        }
                }
            } else
            for (int it = C.gw; it < 2 * DB * KVB; it += C.NGW) {
                const int j = it & (KVB - 1), b = (it >> 11) & 31, kv = it >> 16;
                const bool need = (j >= 1536) || ((j & 15) < 8);
                if (wincopy && !need) continue;
                const float* src = (kv ? cache_v : cache_k) + ((size_t)b * KVB + j) * D + 4 * C.lane;
                float* dst = out + (kv ? O_VS : O_KS) + ((size_t)b * KVB + (j - DT)) * D + 4 * C.lane;
                bf16_t* bd = (kv ? VBS : KBS) + ((size_t)b * SROWS + j) * D + 4 * C.lane;
#pragma unroll
                for (int q = 0; q < 4; ++q) { const f32x4 v = __builtin_nontemporal_load((const f32x4*)(src + 256 * q));
                    if (!wincopy && j >= DT) __builtin_nontemporal_store(v, (f32x4*)(dst + 256 * q));
                    if (need) { u32x2 w; w.x = pk2(v.x, v.y); w.y = pk2(v.z, v.w); *(u32x2*)(bd + 256 * q) = w; } }
            }
            norm_pass(C, 0, x_p, x_s, nullptr, nullptr, 1, nullptr, 0.f, H, norm_g, XN, nullptr, nullptr, nullptr, Rs);
        } else {
            const int l = (ph - 1) / SLOTS, slot = (ph - 1) % SLOTS;
            const bool pool = l < 2; const int j = l - 2;
            const float* gl = norm_g + (size_t)l * 6 * D;
            int gt = -1; const bf16_t* gA = nullptr; const bf16_t* gB = nullptr; int gN = 0, gK = 0, gS = 1; const float* gR = nullptr;
            const bool fuse = MK_ONE_LAUNCH && (C.G == 256);
            const float* np_gpost = nullptr; const float* np_gnext = nullptr; const float* np_gkv = nullptr; float np_alpha = 0.f; float* np_yout = nullptr; int fp = 0;
            switch (slot) {
                case 0: if (l == 2) { gt = 3; gA = H; gB = (const bf16_t*)(ws + WS_WKV); gN = 2 * D; gK = D; } else did = false; break;
                case 1: case 9: { const int li = l * 2 + (slot == 9); gt = 0; gA = H; gB = (const bf16_t*)(ws + WS_FFN + (size_t)li * FFN_STRIDE); gN = 2 * FF; gK = D; } break;
                case 2: case 10: { const int li = l * 2 + (slot == 10); gt = fuse ? 4 : 1; gA = ACT; gB = (const bf16_t*)(ws + WS_FFN + (size_t)li * FFN_STRIDE + WD_OFF); gN = D; gK = FF; gS = 22;
                    if (slot == 2) { np_gpost = gl + D; np_alpha = 0.5f; np_gnext = gl + 2 * D; fp = l * 3; }
                    else { np_gpost = gl + 5 * D; np_alpha = 0.5f; np_gnext = (l < 3) ? gl + 6 * D : gl; np_gkv = (l == 1) ? kv_norm : nullptr; np_yout = (l == 3) ? out : nullptr; fp = l * 3 + 2; } } break;
                case 3: if (fuse) norm_sample_wg<22>(tid_, C.wave, bx_, (LAS float*)(lds + XL_OFF), Pb, gl + D, 0.5f, H, gl + 2 * D, XN, nullptr, nullptr, nullptr, Rs);
                        else norm_pass(C, 1, nullptr, nullptr, Fb, Pb, 22, gl + D, 0.5f, H, gl + 2 * D, XN, nullptr, nullptr, nullptr, Rs, 0); break;
                case 4: if (pool) { gt = 1; gR = Rs; gA = H; gB = (const bf16_t*)(ws + WS_WIN) + (size_t)l * D * D; gN = D; gK = D; gS = 8; }
                        else { gt = 2; gA = H; gB = (const bf16_t*)(ws + WS_WQ) + (size_t)j * NQ * D; gN = NQ; gK = D; } break;
                case 5: if (pool) pool_pass(C, l, Fb, Pb, 8, state, XN2, out); else for (int rep_ = 0; rep_ < REP_ATTN; ++rep_) attn_phase(C, again_ ? PROBE_AMODE : 3, bx_, lds, ACT, KB, VB, KBS, VBS, OG, LSE); break;
                case 6: if (!pool) combine_pass(C, OG, LSE, XN2); else did = false; break;
                case 7: gt = fuse ? 4 : 1; np_gpost = gl + 3 * D; np_alpha = 1.0f; np_gnext = gl + 4 * D; fp = l * 3 + 1; gA = XN2; gB = pool ? (const bf16_t*)(ws + WS_WEFF) + (size_t)l * D * D : (const bf16_t*)(ws + WS_WO) + (size_t)j * D * D; gN = D; gK = D; gS = 8; break;
                case 8: if (fuse) norm_sample_wg<8>(tid_, C.wave, bx_, (LAS float*)(lds + XL_OFF), Pb, gl + 3 * D, 1.0f, H, gl + 4 * D, XN, nullptr, nullptr, nullptr, Rs);
                        else norm_pass(C, 1, nullptr, nullptr, Fb, Pb, 8, gl + 3 * D, 1.0f, H, gl + 4 * D, XN, nullptr, nullptr, nullptr, Rs, 0); break;
                case 11: if (fuse) norm_sample_wg<22>(tid_, C.wave, bx_, (LAS float*)(lds + XL_OFF), Pb, gl + 5 * D, 0.5f, H, (l < 3) ? gl + 6 * D : gl, XN, (l == 1) ? kv_norm : nullptr, XN2, (l == 3) ? out : nullptr, Rs);
                         else norm_pass(C, 1, nullptr, nullptr, Fb, Pb, 22, gl + 5 * D, 0.5f, H, (l < 3) ? gl + 6 * D : gl, XN, (l == 1) ? kv_norm : nullptr, XN2, (l == 3) ? out : nullptr, Rs, 0); break;
                default: break;
            }
            if (gt >= 0) for (int rep_ = 0; rep_ < REP_GEMM; ++rep_) {
                pg8::Sched S; S.init(gA, gB, gN, gK, gS, C.G, bx_); S.sfirst = (gt == 4) ? 1 : 0;
                if (gt == 0) { pg8::EpiSwiglu E{ACT, Rs}; pg8::gemm_phase(lds, S, E, tid_); }
                else if (gt == 1) { pg8::EpiF32 E{Fb, Pb, gR}; pg8::gemm_phase(lds, S, E, tid_); }
                else if (gt == 2) { pg8::EpiQ E{ACT, 0.125f * 1.4426950408889634f, Rs}; pg8::gemm_phase(lds, S, E, tid_); }
                else if (gt == 4) {
                    unsigned* cntw = (unsigned*)(ws + WS_CNT);
                    PanelEx e1{(unsigned*)(ws + WS_X1), cntw, 32u * (unsigned)(fp + 1)};
                    EpiNorm E{Pb, H, np_gpost, np_alpha, np_gnext, XN, np_gkv, XN2, np_yout, e1, lds + XL_OFF, tid_, Rs}; pg8::gemm_phase(lds, S, E, tid_); }
                else { pg8::EpiKV E{out + O_KP, out + O_VP, out + O_KS, out + O_VS, KB, VB, KBS, VBS, Rs}; pg8::gemm_phase(lds, S, E, tid_); }
                if (C.G == 256 && !again_) {
                    int c0 = -1, lo = 0, cnt = 0;
                    if (slot == 1 || slot == 9) { c0 = 150; cnt = CP_Q_UG; lo = (l * 2 + (slot == 9)) * CP_Q_UG; }
                    else if (slot == 4 && !pool) { c0 = 12; cnt = CP_Q_WQ; lo = 8 * CP_Q_UG + j * CP_Q_WQ; }
                    else if (slot == 0) { c0 = 8; cnt = CP_Q_KV; lo = 8 * CP_Q_UG + 2 * CP_Q_WQ; }
                    if (c0 >= 0 && bx_ >= c0) copy_rows(C.lane, (bx_ - c0) * NWAVES + C.wave, (256 - c0) * NWAVES, lo, cnt, cache_k, cache_v, out);
                }
            }
        }
#if MK_ONE_LAUNCH
        if (did && ph + 1 < args.ph_hi) {
            if (ph == 0) { grid.sync(); if (threadIdx.x == 0) (void)xb_add(&xbar.bar[XB_XCNT(xbar.x)], 1u); }
            else xcd_barrier(xbar);
        }
        if (PROBE_SLOT >= 0 && ph > 0 && (ph - 1) % SLOTS == PROBE_SLOT && (ph - 1) / SLOTS >= PROBE_LMIN && (ph - 1) / SLOTS <= PROBE_LMAX && !again_) { again_ = 1; --ph; } else again_ = 0;
#endif
    }
}

extern "C" void kernel_launch(void* const* d_in, const int* in_sizes, int n_in, void* d_out, int out_size, void* d_ws, size_t ws_size, hipStream_t stream) {
    static int grid = 0;
    if (grid == 0) {
        if (n_in != 18 || ws_size < WS_END) { fprintf(stderr, "kernel_launch: unexpected inputs (n_in %d, ws %zu < %zu)\n", n_in, ws_size, (size_t)WS_END); grid = -1; return; }
        int dev = 0, cus = 0;
        if (hipGetDevice(&dev) != hipSuccess || hipDeviceGetAttribute(&cus, hipDeviceAttributeMultiprocessorCount, dev) != hipSuccess) { grid = -1; return; }
        if (hipFuncSetAttribute((const void*)yoco_fwd, hipFuncAttributeMaxDynamicSharedMemorySize, LDS_BYTES) != hipSuccess) { fprintf(stderr, "kernel_launch: hipFuncSetAttribute failed\n"); grid = -1; return; }
        int per_cu = 0;
        if (hipOccupancyMaxActiveBlocksPerMultiprocessor(&per_cu, (const void*)yoco_fwd, NWAVES * 64, LDS_BYTES) != hipSuccess || per_cu < 1) { fprintf(stderr, "kernel_launch: occupancy query says %d\n", per_cu); per_cu = 1; }
        (void)hipGetLastError();
        grid = cus;
    }
    if (grid < 0) return;
#if MK_ONE_LAUNCH
#endif
    Args a{};
    for (int i = 0; i < 18; ++i) a.in[i] = (const float*)d_in[i];
    a.out = (float*)d_out; a.ws = (unsigned char*)d_ws;
#if MK_ONE_LAUNCH
    a.ph_lo = 0; a.ph_hi = NPH;
    void* kargs[] = {&a};
    hipError_t e = hipLaunchCooperativeKernel((const void*)yoco_fwd, dim3(grid), dim3(NWAVES * 64), kargs, LDS_BYTES, stream);
    if (e != hipSuccess) fprintf(stderr, "kernel_launch: cooperative launch failed: %s (grid %d)\n", hipGetErrorString(e), grid);
#else
    for (int ph = 0; ph < NPH; ++ph) {
        if (ph > 0) { const int l = (ph - 1) / SLOTS, slot = (ph - 1) % SLOTS; if ((slot == 0 && l != 2) || (slot == 6 && l < 2)) continue; }
        a.ph_lo = ph; a.ph_hi = ph + 1;
        hipLaunchKernelGGL(yoco_fwd, dim3(grid), dim3(NWAVES * 64), LDS_BYTES, stream, a);
    }
#endif
}
```
